# Optimizing an MI355X kernel written in HIP

```python
import jax, jax.numpy as jnp
from jax import lax
import numpy as np

D_MODEL = 1024
BATCH = 8
SEQ = 2048
DEPTH = 1

CONV_DIM = 512
CONV_WIDTH = 31
GLA_HEADS = 4
GLA_DK = 128
GLA_DV = 256
GLA_LOWRANK = 16
GLA_TAU = 16.0
GLA_CHUNK = 64
QK_DIM = GLA_HEADS * GLA_DK
V_DIM = GLA_HEADS * GLA_DV
N_BRANCH = 2
N_GROUPS = 4
EXPERTS_PER_GROUP = 8
N_EXPERTS = N_GROUPS * EXPERTS_PER_GROUP
TOP_K = 2
D_EXPERT = 512
EPS = 1e-6
N_MOD = 6
IN_SIZES = (2 * CONV_DIM, QK_DIM, QK_DIM, V_DIM, V_DIM, GLA_LOWRANK, N_BRANCH * D_MODEL)
IN_DIM = 2 * CONV_DIM + 2 * QK_DIM + 2 * V_DIM + GLA_LOWRANK + N_BRANCH * D_MODEL

kernel_name = "hybrid_conv_gla_hmoe_adaln_block"


def rmsnorm(x, g):
    x32 = x.astype(jnp.float32)
    y = x32 * lax.rsqrt(jnp.mean(x32 * x32, axis=-1, keepdims=True) + EPS)
    return (y * g.astype(jnp.float32)).astype(x.dtype)


def layernorm(x, g, b):
    x32 = x.astype(jnp.float32)
    mu = jnp.mean(x32, axis=-1, keepdims=True)
    xc = x32 - mu
    var = jnp.mean(xc * xc, axis=-1, keepdims=True)
    y = xc * lax.rsqrt(var + EPS) * g.astype(jnp.float32) + b.astype(jnp.float32)
    return y.astype(x.dtype)


def modulate(x, shift, scale):
    return x * (1.0 + scale[:, None, :]) + shift[:, None, :]


def conv_module(u, w_dw, b_dw, ln_g, ln_b, w_pw, b_pw):
    a, gt = jnp.split(u, 2, axis=-1)
    z = a * jax.nn.sigmoid(gt)
    z = lax.conv_general_dilated(
        z, w_dw, window_strides=(1,), padding=[(CONV_WIDTH - 1, 0)],
        dimension_numbers=("NWC", "WIO", "NWC"), feature_group_count=CONV_DIM) + b_dw
    z = jax.nn.silu(layernorm(z, ln_g, ln_b))
    return z @ w_pw + b_pw


def gla_chunked(q, k, v, logg):
    B, S, H, _ = q.shape
    n_chunks = S // GLA_CHUNK

    def to_chunks(t):
        return t.reshape(B, n_chunks, GLA_CHUNK, H, t.shape[-1]).transpose(1, 0, 3, 2, 4)

    causal = jnp.tril(jnp.ones((GLA_CHUNK, GLA_CHUNK), dtype=bool))[:, :, None]

    def step(state, inp):
        qc, kc, vc, gc = inp
        b = jnp.cumsum(gc, axis=2)
        o_inter = jnp.einsum("bhcd,bhde->bhce", qc * jnp.exp(b), state)
        diff = b[:, :, :, None, :] - b[:, :, None, :, :]
        decay = jnp.exp(jnp.where(causal, diff, -jnp.inf))
        attn = jnp.einsum("bhid,bhijd,bhjd->bhij", qc, decay, kc)
        o_intra = jnp.einsum("bhij,bhje->bhie", attn, vc)
        b_last = b[:, :, -1:, :]
        new_state = (jnp.exp(b_last[:, :, 0, :])[..., None] * state
                     + jnp.einsum("bhcd,bhce->bhde", kc * jnp.exp(b_last - b), vc))
        return new_state, o_inter + o_intra

    state0 = jnp.zeros((B, H, q.shape[-1], v.shape[-1]), jnp.float32)
    _, outs = lax.scan(step, state0, (to_chunks(q), to_chunks(k), to_chunks(v), to_chunks(logg)))
    return outs.transpose(1, 0, 3, 2, 4).reshape(B, S, H, v.shape[-1])


def hybrid_mixer(u, w_in, w_dw, b_dw, g_conv_ln, b_conv_ln, w_conv_pw, b_conv_pw,
                 w_a2, b_a2, g_gla_norm, w_gla_o, w_out):
    B, S, _ = u.shape
    proj = u @ w_in
    offs = np.cumsum(IN_SIZES)[:-1].tolist()
    p_conv, q, k, v, r, a1, gates = jnp.split(proj, offs, axis=-1)
    y_conv = conv_module(p_conv, w_dw, b_dw, g_conv_ln, b_conv_ln, w_conv_pw, b_conv_pw)
    q = q.reshape(B, S, GLA_HEADS, GLA_DK).astype(jnp.float32) * (GLA_DK ** -0.5)
    k = k.reshape(B, S, GLA_HEADS, GLA_DK).astype(jnp.float32)
    v = v.reshape(B, S, GLA_HEADS, GLA_DV).astype(jnp.float32)
    logg = jax.nn.log_sigmoid((a1 @ w_a2 + b_a2).astype(jnp.float32)) / GLA_TAU
    logg = logg.reshape(B, S, GLA_HEADS, GLA_DK)
    o = gla_chunked(q, k, v, logg)
    o = rmsnorm(o, g_gla_norm.reshape(GLA_HEADS, GLA_DV)).reshape(B, S, V_DIM).astype(u.dtype)
    y_gla = (o * jax.nn.silu(r)) @ w_gla_o
    gt = jax.nn.sigmoid(gates).reshape(B, S, N_BRANCH, D_MODEL)
    merged = gt[:, :, 0, :] * y_conv + gt[:, :, 1, :] * y_gla
    return merged @ w_out


def hierarchical_moe(h, w_rg, b_rg, w_re, b_re, w1, w3, w2):
    B, S, D = h.shape
    t = h.reshape(B * S, D)
    lg = (t @ w_rg + b_rg).astype(jnp.float32)
    pg = jax.nn.softmax(lg, axis=-1)
    _, gsel = lax.top_k(lg, 1)
    wg = jnp.take_along_axis(pg, gsel, axis=1)
    le = (t @ w_re + b_re).astype(jnp.float32).reshape(-1, N_GROUPS, EXPERTS_PER_GROUP)
    le_sel = jnp.take_along_axis(le, gsel[:, :, None], axis=1)[:, 0, :]
    top_v, top_i = lax.top_k(le_sel, TOP_K)
    w = jax.nn.softmax(top_v, axis=-1) * wg
    eid = gsel * EXPERTS_PER_GROUP + top_i
    comb = jnp.einsum("tk,tke->te", w, jax.nn.one_hot(eid, N_EXPERTS, dtype=jnp.float32))
    y = jnp.zeros((B * S, D), jnp.float32)
    for e in range(N_EXPERTS):
        hid = jax.nn.silu(t @ w1[e]) * (t @ w3[e])
        y = y + comb[:, e:e + 1] * (hid @ w2[e]).astype(jnp.float32)
    return y.astype(h.dtype).reshape(B, S, D)


def setup_inputs(seed: int = 0) -> dict:
    key = jax.random.key(seed)
    ks = jax.random.split(key, 32)
    f32 = jnp.float32
    L, D = DEPTH, D_MODEL

    def nrm(k, shape, scale):
        return jax.random.normal(k, shape, f32) * scale

    def gain(k, shape):
        return 1.0 + 0.05 * jax.random.normal(k, shape, f32)

    return {
        "x": jax.random.normal(ks[0], (BATCH, SEQ, D), f32),
        "c": jax.random.normal(ks[1], (BATCH, D), f32),
        "w_ada": nrm(ks[2], (L, D, N_MOD * D), 0.5 * D ** -0.5),
        "b_ada": nrm(ks[3], (L, N_MOD * D), 0.02),
        "g_norm1": gain(ks[4], (L, D)),
        "w_in": nrm(ks[5], (L, D, IN_DIM), D ** -0.5),
        "w_dw": nrm(ks[6], (L, CONV_WIDTH, 1, CONV_DIM), CONV_WIDTH ** -0.5),
        "b_dw": nrm(ks[7], (L, CONV_DIM), 0.02),
        "g_conv_ln": gain(ks[8], (L, CONV_DIM)),
        "b_conv_ln": nrm(ks[9], (L, CONV_DIM), 0.02),
        "w_conv_pw": nrm(ks[10], (L, CONV_DIM, D), CONV_DIM ** -0.5),
        "b_conv_pw": nrm(ks[11], (L, D), 0.02),
        "w_a2": nrm(ks[12], (L, GLA_LOWRANK, QK_DIM), GLA_LOWRANK ** -0.5),
        "b_a2": nrm(ks[13], (L, QK_DIM), 0.02),
        "g_gla_norm": gain(ks[14], (L, V_DIM)),
        "w_gla_o": nrm(ks[15], (L, V_DIM, D), V_DIM ** -0.5),
        "w_out": nrm(ks[16], (L, D, D), D ** -0.5),
        "g_norm2": gain(ks[17], (L, D)),
        "w_router_g": nrm(ks[18], (L, D, N_GROUPS), D ** -0.5),
        "b_router_g": nrm(ks[19], (L, N_GROUPS), 0.01),
        "w_router_e": nrm(ks[20], (L, D, N_EXPERTS), D ** -0.5),
        "b_router_e": nrm(ks[21], (L, N_EXPERTS), 0.01),
        "w1": nrm(ks[22], (L, N_EXPERTS, D, D_EXPERT), D ** -0.5),
        "w3": nrm(ks[23], (L, N_EXPERTS, D, D_EXPERT), D ** -0.5),
        "w2": nrm(ks[24], (L, N_EXPERTS, D_EXPERT, D), D_EXPERT ** -0.5),
        "w_ada_f": nrm(ks[25], (D, 2 * D), 0.5 * D ** -0.5),
        "b_ada_f": nrm(ks[26], (2 * D,), 0.02),
        "g_final": gain(ks[27], (D,)),
    }


def reference(x, c, w_ada, b_ada, g_norm1, w_in, w_dw, b_dw, g_conv_ln, b_conv_ln,
              w_conv_pw, b_conv_pw, w_a2, b_a2, g_gla_norm, w_gla_o, w_out, g_norm2,
              w_router_g, b_router_g, w_router_e, b_router_e, w1, w3, w2,
              w_ada_f, b_ada_f, g_final):
    h = x
    c_act = jax.nn.silu(c)
    for l in range(DEPTH):
        mod = c_act @ w_ada[l] + b_ada[l]
        sh1, sc1, ga1, sh2, sc2, ga2 = jnp.split(mod, N_MOD, axis=-1)
        u = modulate(rmsnorm(h, g_norm1[l]), sh1, sc1)
        y = hybrid_mixer(u, w_in[l], w_dw[l], b_dw[l], g_conv_ln[l], b_conv_ln[l],
                         w_conv_pw[l], b_conv_pw[l], w_a2[l], b_a2[l], g_gla_norm[l],
                         w_gla_o[l], w_out[l])
        h = h + ga1[:, None, :] * y
        u2 = modulate(rmsnorm(h, g_norm2[l]), sh2, sc2)
        y2 = hierarchical_moe(u2, w_router_g[l], b_router_g[l], w_router_e[l], b_router_e[l],
                              w1[l], w3[l], w2[l])
        h = h + ga2[:, None, :] * y2
    modf = c_act @ w_ada_f + b_ada_f
    shf, scf = jnp.split(modf, 2, axis=-1)
    return modulate(rmsnorm(h, g_final), shf, scf)
```

```cpp
#include <hip/hip_runtime.h>
#include <cstdio>
#include <cstdint>

#ifndef MK_N_LAUNCHES
#define MK_N_LAUNCHES 1
#endif

#define LAS __attribute__((address_space(3)))
#define GAS __attribute__((address_space(1)))
typedef unsigned short bf16_t;
typedef short bf16x8 __attribute__((ext_vector_type(8)));
typedef float f32x4 __attribute__((ext_vector_type(4)));
typedef float f32x2 __attribute__((ext_vector_type(2)));
typedef unsigned u32x4 __attribute__((ext_vector_type(4)));
typedef unsigned u32x2 __attribute__((ext_vector_type(2)));

constexpr int BATCH = 8, SEQ = 2048, DM = 1024, T = BATCH * SEQ;
constexpr int CONV_DIM = 512, CONV_W = 31, NH = 4, DK = 128, DV = 256, LOWRANK = 16, QKD = 512, VD = 1024;
constexpr int NE = 32, NGRP = 4, EPG = 8, DE = 512, NMOD = 6;
constexpr int IN_DIM = 6160, NPROJ = 6144;
constexpr float EPS = 1e-6f;
constexpr int SLOT_CAP = 2 * T + NE * 256;

constexpr size_t MiB = 1u << 20;
constexpr size_t WS_CTL = 0, CTL_ZERO_BYTES = 1 * MiB;
constexpr size_t WS_MOD = 1 * MiB;
constexpr size_t WS_LIST = 2 * MiB;
constexpr size_t WS_TOK = 4 * MiB;
constexpr size_t WS_WPW = 5 * MiB, WS_WGO = 6 * MiB, WS_WOUT = 8 * MiB, WS_WIN = 10 * MiB;
constexpr size_t WS_W13 = 22 * MiB, WS_W2 = 86 * MiB;
constexpr size_t WS_U = 118 * MiB;
constexpr size_t WS_Q = 150 * MiB, WS_K = 166 * MiB;
constexpr size_t WS_V = 182 * MiB;
constexpr size_t WS_RS = 214 * MiB;
constexpr size_t WS_LG = 246 * MiB;
constexpr size_t WS_Z = 278 * MiB, WS_Z2 = 294 * MiB;
constexpr size_t WS_HID = WS_V;
constexpr size_t WS_Y = 222 * MiB;
constexpr size_t WS_END = 310 * MiB;
constexpr int CW_CNT = 64;
constexpr int CW_BAR = 4096;

constexpr int LDS_BYTES = 163840;
constexpr int RING_BYTES = 131072;
constexpr int MISC_OFF = LDS_BYTES - 512;
constexpr int TBL_OFF = RING_BYTES;

constexpr int NWAVES = 8, NTHR = 512;

__device__ __forceinline__ unsigned cvt_pk_bf16(float lo, float hi) { unsigned r; asm volatile("v_cvt_pk_bf16_f32 %0, %1, %2" : "=v"(r) : "v"(lo), "v"(hi)); return r; }
__device__ __forceinline__ float bf2f(unsigned short b) { return __uint_as_float(((unsigned)b) << 16); }
__device__ __forceinline__ float bflo(unsigned w) { return __uint_as_float(w << 16); }
__device__ __forceinline__ float bfhi(unsigned w) { return __uint_as_float(w & 0xffff0000u); }
__device__ __forceinline__ float sigmoidf_(float x) { return __builtin_amdgcn_rcpf(1.0f + __expf(-x)); }
__device__ __forceinline__ float siluf_(float x) { return x * sigmoidf_(x); }
__device__ __forceinline__ float wave_sum(float v) {
#pragma unroll
    for (int o = 1; o < 64; o <<= 1) v += __shfl_xor(v, o);
    return v;
}
#define LDS_WAIT() asm volatile("s_waitcnt lgkmcnt(0)" ::: "memory")
#define VM_WAIT() asm volatile("s_waitcnt vmcnt(0)" ::: "memory")

namespace pg8 {
constexpr int BM = 256, BK = 64, HALF = 128, HTB = HALF * BK * 2, STAGE_BYTES = 8 * HTB, NXCD = 8, WGM = 8;
__host__ __device__ __forceinline__ int lds_byte(int r, int c) { const int st = (r >> 4) * 2 + (c >> 5), rr = r & 15, cc = c & 31, ob = rr * 64 + cc * 2; return st * 1024 + (ob ^ (((ob >> 9) & 1) << 5)); }
__host__ __device__ __forceinline__ void stage_rc(int b, int& R, int& C) { const int st = b / 1024, sb = b % 1024, swz = sb ^ (((sb >> 9) & 1) << 5); R = (st >> 1) * 16 + swz / 64; C = (st & 1) * 32 + (swz % 64) / 2; }
__host__ __device__ __forceinline__ int perm32(int rho) { const int n = rho >> 4, i = rho & 15; return 8 * (i >> 2) + 4 * n + (i & 3); }

struct Unit { int pm, pn; const char* pa; const char* pb; const int* rows; int nvalid; };

struct DenseOrder {
    const char* A; const char* Bt; int K, nM, nN, nwg, G, c;
    __device__ __forceinline__ void init(const void* A_, const void* Bt_, int M, int N, int K_, int G_, int c_) { A = (const char*)A_; Bt = (const char*)Bt_; K = K_; nM = M / BM; nN = N / BM; nwg = nM * nN; G = G_; c = c_; }
    __device__ __forceinline__ bool next(int i, Unit& u) const {
        const long L = (long)i * G + c; if (L >= nwg) return false;
        int wgid = (int)L; { const int q = nwg / NXCD, r = nwg % NXCD, xcd = wgid % NXCD, off = wgid / NXCD; wgid = (xcd < r ? xcd * (q + 1) : r * (q + 1) + (xcd - r) * q) + off; }
        const int nig = WGM * nN, gid = wgid / nig, fm = gid * WGM, gsz = (nM - fm) < WGM ? (nM - fm) : WGM;
        u.pm = fm + ((wgid % nig) % gsz); u.pn = (wgid % nig) / gsz;
        u.pa = A + (size_t)u.pm * BM * K * 2; u.pb = Bt + (size_t)u.pn * BM * K * 2; u.rows = nullptr; u.nvalid = 256; return true;
    }
};

template <class Epi, class Sched, bool GATHER>
__device__ __forceinline__ void gemm_phase(LAS unsigned char* lds, const int K, const Sched& S, const Epi& E) {
    const int tid = threadIdx.x, wid = __builtin_amdgcn_readfirstlane(tid >> 6), lane = tid & 63, wr = wid >> 2, wc = wid & 3, fr = lane & 15, fq = lane >> 4;
    const int nt = K / BK;
    unsigned voffA[2], voffB[2]; int rA[2]; unsigned cA2[2];
#pragma unroll
    for (int i = 0; i < 2; ++i) { int R, C; stage_rc(tid * 16 + i * 8192, R, C); const int Rb = Epi::PERM ? ((R & ~31) + perm32(R & 31)) : R;
        voffA[i] = (unsigned)(R * K + C) * 2u; voffB[i] = (unsigned)(Rb * K + C) * 2u; rA[i] = R; cA2[i] = (unsigned)C * 2u; }
    unsigned voffG[2][2] = {{0u, 0u}, {0u, 0u}}, voffGn[2][2] = {{0u, 0u}, {0u, 0u}};
    const size_t kstep = (size_t)(BK * 2);
    const size_t hstep = (size_t)HALF * K * 2;
    const unsigned ldsw = (unsigned)wid * 1024u;
    const int aoff = lds_byte(wr * 64 + fr, fq * 8), boff = lds_byte(wc * 32 + fr, fq * 8);
#define PG8_SA(b, h) (((b) * 2 + (h)) * HTB)
#define PG8_SB(b, h) ((4 + (b) * 2 + (h)) * HTB)
#define PG8_STAGE(bufoff, gbase, voff) do { _Pragma("unroll") for (int _i = 0; _i < 2; ++_i) \
        __builtin_amdgcn_global_load_lds((const unsigned*)((const char*)(gbase) + (voff)[_i]), (LAS unsigned*)(lds + (bufoff) + ldsw + _i * 8192), 16, 0, 0); } while (0)
#define PG8_STAGE_A(bufoff, kptr, h) do { if constexpr (GATHER) { PG8_STAGE(bufoff, kptr, voffG[h]); } else { PG8_STAGE(bufoff, (kptr) + (h) * hstep, voffA); } } while (0)
#define PG8_LDA(dst, b, h) do { _Pragma("unroll") for (int m = 0; m < 4; ++m) _Pragma("unroll") for (int k = 0; k < 2; ++k) dst[m][k] = *(const LAS bf16x8*)(lds + PG8_SA(b, h) + aoff + m * 2048 + k * 1024); } while (0)
#define PG8_LDB(dst, b, h) do { _Pragma("unroll") for (int n = 0; n < 2; ++n) _Pragma("unroll") for (int k = 0; k < 2; ++k) dst[n][k] = *(const LAS bf16x8*)(lds + PG8_SB(b, h) + boff + n * 2048 + k * 1024); } while (0)
#define PG8_MMA(ai, bj, At, Bt) do { __builtin_amdgcn_s_setprio(1); _Pragma("unroll") for (int m = 0; m < 4; ++m) _Pragma("unroll") for (int n = 0; n < 2; ++n) _Pragma("unroll") for (int k = 0; k < 2; ++k) \
        acc[ai][bj][m][n] = __builtin_amdgcn_mfma_f32_16x16x32_bf16(Bt[n][k], At[m][k], acc[ai][bj][m][n], 0, 0, 0); __builtin_amdgcn_s_setprio(0); } while (0)
#define PG8_WAIT_V(n) asm volatile("s_waitcnt vmcnt(" #n ")" ::: "memory")
#define PG8_WAIT_L(n) asm volatile("s_waitcnt lgkmcnt(" #n ")" ::: "memory")
#define PG8_BAR __builtin_amdgcn_s_barrier()
#define PG8_SCHED __builtin_amdgcn_sched_barrier(0)
#define PG8_LOADROWS(dst, u) do { _Pragma("unroll") for (int _h = 0; _h < 2; ++_h) _Pragma("unroll") for (int _i = 0; _i < 2; ++_i) { const int _r = _h * HALF + rA[_i]; \
        const int _idx = (_r < (u).nvalid) ? (u).rows[_r] : 0; dst[_h][_i] = (unsigned)_idx * (unsigned)(K * 2) + cA2[_i]; } } while (0)
    Unit cur, nxt; int ui = 0;
    if (!S.next(0, cur)) return;
    f32x4 acc[2][2][4][2];
#pragma unroll
    for (int a = 0; a < 2; ++a)
#pragma unroll
        for (int b = 0; b < 2; ++b)
#pragma unroll
            for (int m = 0; m < 4; ++m)
#pragma unroll
                for (int n = 0; n < 2; ++n) acc[a][b][m][n] = (f32x4){0.f, 0.f, 0.f, 0.f};
    bf16x8 At[4][2], B0[2][2], B1[2][2];
    const char* cA = cur.pa; const char* cB = cur.pb;
    if constexpr (GATHER) { PG8_LOADROWS(voffG, cur); }
    PG8_STAGE(PG8_SB(0, 0), cB, voffB); PG8_STAGE(PG8_SB(0, 1), cB + hstep, voffB); PG8_STAGE_A(PG8_SA(0, 0), cA, 0); PG8_STAGE_A(PG8_SA(0, 1), cA, 1);
    if (wr == 1) PG8_BAR;
    PG8_WAIT_V(2); PG8_BAR;
    PG8_STAGE(PG8_SB(1, 0), cB + kstep, voffB); PG8_STAGE_A(PG8_SA(1, 0), cA + kstep, 0); PG8_STAGE(PG8_SB(1, 1), cB + hstep + kstep, voffB);
    PG8_WAIT_V(6); PG8_BAR;
    for (;;) {
        const bool has_next = S.next(ui + 1, nxt);
        const char* nA = has_next ? nxt.pa : cA; const char* nB = has_next ? nxt.pb : cB;
        if constexpr (GATHER) { if (has_next) { PG8_LOADROWS(voffGn, nxt); } }
        for (int t = 0; t < nt; t += 2) {
            const bool last = (t == nt - 2);
            const char* a1 = cA + (size_t)(t + 1) * kstep;
            const char* a2 = last ? nA : cA + (size_t)(t + 2) * kstep; const char* b2 = last ? nB : cB + (size_t)(t + 2) * kstep;
            const char* a3 = a2 + kstep; const char* b3 = b2 + kstep;
            PG8_LDB(B0, 0, 0); PG8_LDB(B1, 0, 1); PG8_SCHED; PG8_LDA(At, 0, 0); PG8_STAGE_A(PG8_SA(1, 1), a1, 1);
            if constexpr (GATHER) { if (last && has_next) {
#pragma unroll
                for (int _h = 0; _h < 2; ++_h)
#pragma unroll
                    for (int _i = 0; _i < 2; ++_i) voffG[_h][_i] = voffGn[_h][_i]; } }
            PG8_WAIT_V(8); PG8_WAIT_L(0); PG8_BAR; PG8_MMA(0, 0, At, B0); PG8_MMA(0, 1, At, B1); PG8_BAR; PG8_SCHED;
            PG8_LDA(At, 0, 1); PG8_STAGE(PG8_SB(0, 0), b2, voffB); PG8_STAGE(PG8_SB(0, 1), b2 + hstep, voffB); PG8_STAGE_A(PG8_SA(0, 0), a2, 0);
            PG8_WAIT_V(8); PG8_WAIT_L(0); PG8_BAR; PG8_MMA(1, 0, At, B0); PG8_MMA(1, 1, At, B1); PG8_BAR; PG8_SCHED;
            PG8_LDB(B0, 1, 0); PG8_LDB(B1, 1, 1); PG8_SCHED; PG8_LDA(At, 1, 0); PG8_STAGE_A(PG8_SA(0, 1), a2, 1);
            PG8_WAIT_V(8); PG8_WAIT_L(0); PG8_BAR; PG8_MMA(0, 0, At, B0); PG8_MMA(0, 1, At, B1); PG8_BAR; PG8_SCHED;
            PG8_LDA(At, 1, 1); PG8_STAGE(PG8_SB(1, 0), b3, voffB); PG8_STAGE(PG8_SB(1, 1), b3 + hstep, voffB); PG8_STAGE_A(PG8_SA(1, 0), a3, 0);
            PG8_WAIT_V(8); PG8_WAIT_L(0); PG8_BAR; PG8_MMA(1, 0, At, B0); PG8_MMA(1, 1, At, B1); PG8_BAR; PG8_SCHED;
        }
        if (wr == 0) PG8_BAR;
        E(acc, cur, wr, wc, fr, fq);
        if (!has_next) break;
#pragma unroll
        for (int a = 0; a < 2; ++a)
#pragma unroll
            for (int b = 0; b < 2; ++b)
#pragma unroll
                for (int m = 0; m < 4; ++m)
#pragma unroll
                    for (int n = 0; n < 2; ++n) acc[a][b][m][n] = (f32x4){0.f, 0.f, 0.f, 0.f};
        cur = nxt; cA = nA; cB = nB; ++ui;
        if (wr == 1) PG8_BAR;
    }
    PG8_WAIT_V(0);
    PG8_BAR;
#undef PG8_SA
#undef PG8_SB
#undef PG8_STAGE
#undef PG8_STAGE_A
#undef PG8_LDA
#undef PG8_LDB
#undef PG8_MMA
#undef PG8_WAIT_V
#undef PG8_WAIT_L
#undef PG8_BAR
#undef PG8_SCHED
#undef PG8_LOADROWS
}
}

#define XB_TMO      128
#define XB_XCNT(j)  (256  + 64 * (j))
#define XB_XSUB(j)  (1280 + 64 * (j))
#define XB_XGEN(j)  (2304 + 64 * (j))
#define XB_TOP      3328
#define XB_TOPGEN   3392
#define XCD_BAR_WORDS 3456
#define XB_SPIN_CAP (1u << 18)
__device__ __forceinline__ unsigned xb_ld(unsigned* p)              { return __hip_atomic_load(p, __ATOMIC_RELAXED, __HIP_MEMORY_SCOPE_AGENT); }
__device__ __forceinline__ unsigned xb_add(unsigned* p, unsigned v) { return __hip_atomic_fetch_add(p, v, __ATOMIC_RELAXED, __HIP_MEMORY_SCOPE_AGENT); }
__device__ __forceinline__ unsigned xb_xcc_id() { return (unsigned)__builtin_amdgcn_s_getreg((3 << 11) | 20) & 0xFu; }
#define XB_SPIN(cond, bar) do { unsigned _sp = 0; while (cond) { __builtin_amdgcn_s_sleep(1); \
    if ((++_sp & 255u) == 0u) { if (xb_ld(&(bar)[XB_TMO])) break; if (_sp > XB_SPIN_CAP) { atomicAdd(&(bar)[XB_TMO], 1u); break; } } } } while (0)
struct XcdBarrier { unsigned* bar; unsigned x; volatile LAS unsigned* st; };
__device__ __forceinline__ XcdBarrier xcd_barrier_post(unsigned* bar, volatile LAS unsigned* st) {
    XcdBarrier b; b.bar = bar; b.x = xb_xcc_id(); b.st = st;
    if (threadIdx.x == 0) (void)xb_add(&bar[XB_XCNT(b.x)], 1u);
    return b;
}
__device__ __forceinline__ void xcd_barrier_complete(unsigned* bar, unsigned x, unsigned& nloc, unsigned& nx) {
    const unsigned G = gridDim.x * gridDim.y * gridDim.z;
    unsigned sum, cnt, mine, sp = 0u;
    for (;;) {
        sum = 0u; cnt = 0u; mine = 0u;
#pragma unroll
        for (unsigned j = 0; j < 16; ++j) { const unsigned c = xb_ld(&bar[XB_XCNT(j)]); sum += c; cnt += (c > 0u) ? 1u : 0u; mine = (j == x) ? c : mine; }
        if (sum == G) break;
        __builtin_amdgcn_s_sleep(1);
        if ((++sp & 255u) == 0u) { if (xb_ld(&bar[XB_TMO])) break; if (sp > XB_SPIN_CAP) { atomicAdd(&bar[XB_TMO], 1u); break; } }
    }
    nloc = mine > 0u ? mine : 1u; nx = cnt > 0u ? cnt : 1u;
}
__device__ __forceinline__ void xcd_barrier(const XcdBarrier& b) {
    asm volatile("s_waitcnt vmcnt(0)" ::: "memory");
    __syncthreads();
    if (threadIdx.x == 0) {
        unsigned* bar = b.bar;
        __builtin_amdgcn_s_waitcnt(0);
        unsigned nloc = b.st[0], nx = b.st[1];
        if (nloc == 0u) { xcd_barrier_complete(bar, b.x, nloc, nx); b.st[0] = nloc; b.st[1] = nx; }
        const unsigned old = xb_add(&bar[XB_XSUB(b.x)], 1u);
        const unsigned gen = old / nloc;
        if (old + 1u == (gen + 1u) * nloc) {
            __builtin_amdgcn_fence(__ATOMIC_RELEASE, "agent");
            asm volatile("s_waitcnt vmcnt(0)" ::: "memory");
            const unsigned og = xb_add(&bar[XB_TOP], 1u);
            const unsigned tg = og / nx;
            if (og + 1u == (tg + 1u) * nx) xb_add(&bar[XB_TOPGEN], 1u);
            else XB_SPIN(xb_ld(&bar[XB_TOPGEN]) == tg, bar);
            __builtin_amdgcn_fence(__ATOMIC_ACQUIRE, "agent");
            xb_add(&bar[XB_XGEN(b.x)], 1u);
            asm volatile("s_waitcnt vmcnt(0)" ::: "memory");
        } else {
            XB_SPIN(xb_ld(&bar[XB_XGEN(b.x)]) == gen, bar);
            __builtin_amdgcn_fence(__ATOMIC_ACQUIRE, "agent");
            asm volatile("s_waitcnt vmcnt(0)" ::: "memory");
        }
    }
    __syncthreads();
}

struct Frame {
    LAS unsigned char* lds;
    volatile LAS unsigned* MISC;
    unsigned* ctl;
    int tid, lane, wave, G, bid;
    const float* in[28]; float* out; unsigned char* ws;
};
#define IN_X 0
#define IN_C 1
#define IN_WADA 2
#define IN_BADA 3
#define IN_GN1 4
#define IN_WIN 5
#define IN_WDW 6
#define IN_BDW 7
#define IN_GCLN 8
#define IN_BCLN 9
#define IN_WPW 10
#define IN_BPW 11
#define IN_WA2 12
#define IN_BA2 13
#define IN_GGLA 14
#define IN_WGO 15
#define IN_WOUT 16
#define IN_GN2 17
#define IN_WRG 18
#define IN_BRG 19
#define IN_WRE 20
#define IN_BRE 21
#define IN_W1 22
#define IN_W3 23
#define IN_W2 24
#define IN_WADAF 25
#define IN_BADAF 26
#define IN_GFIN 27

__device__ __forceinline__ void st_bf16x8(bf16_t* p, f32x4 v0, f32x4 v1) {
    u32x4 w; w.x = cvt_pk_bf16(v0[0], v0[1]); w.y = cvt_pk_bf16(v0[2], v0[3]); w.z = cvt_pk_bf16(v1[0], v1[1]); w.w = cvt_pk_bf16(v1[2], v1[3]);
    *(u32x4*)p = w;
}
__device__ __forceinline__ void ld_bf16x8(const bf16_t* p, f32x4& v0, f32x4& v1) {
    const u32x4 w = *(const u32x4*)p;
    v0 = (f32x4){bflo(w.x), bfhi(w.x), bflo(w.y), bfhi(w.y)}; v1 = (f32x4){bflo(w.z), bfhi(w.z), bflo(w.w), bfhi(w.w)};
}
__device__ __forceinline__ f32x4 sig4(f32x4 v) { return (f32x4){sigmoidf_(v[0]), sigmoidf_(v[1]), sigmoidf_(v[2]), sigmoidf_(v[3])}; }
__device__ __forceinline__ f32x4 silu4(f32x4 v) { return (f32x4){siluf_(v[0]), siluf_(v[1]), siluf_(v[2]), siluf_(v[3])}; }

struct EpiProj {
    static constexpr bool PERM = true;
    unsigned char* ws; unsigned char* outp;
    __device__ __forceinline__ void operator()(const f32x4 (&acc)[2][2][4][2], const pg8::Unit& u, int wr, int wc, int fr, int fq) const {
        const int row0 = u.pm * 256 + wr * 64 + fr, c8 = wc * 32 + 8 * fq, pn = u.pn;
        if (pn < 4) {
            bf16_t* Z = (bf16_t*)(ws + WS_Z);
#pragma unroll
            for (int ai = 0; ai < 2; ++ai)
#pragma unroll
                for (int m = 0; m < 4; ++m) { const int row = row0 + ai * 128 + m * 16;
                    const f32x4 z0 = acc[ai][0][m][0] * sig4(acc[ai][1][m][0]), z1 = acc[ai][0][m][1] * sig4(acc[ai][1][m][1]);
                    st_bf16x8(Z + (size_t)row * CONV_DIM + 128 * pn + c8, z0, z1); }
        } else {
            int ld, col0, act; size_t boff;
            if (pn < 8) { ld = QKD; col0 = ((pn - 4) & 1) * 256; boff = WS_Q + (size_t)((pn - 4) >> 1) * (WS_K - WS_Q); act = 0; }
            else if (pn < 16) { ld = VD; col0 = ((pn - 8) & 3) * 256; boff = WS_V + (size_t)((pn - 8) >> 2) * (WS_RS - WS_V); act = (pn >= 12) ? 1 : 0; }
            else { ld = 2 * DM; col0 = (pn - 16) * 256; boff = 0; act = 2; }
            bf16_t* base = (bf16_t*)(((pn >= 16) ? outp : ws) + boff);
#pragma unroll
            for (int ai = 0; ai < 2; ++ai)
#pragma unroll
                for (int m = 0; m < 4; ++m) { const int row = row0 + ai * 128 + m * 16;
#pragma unroll
                    for (int bj = 0; bj < 2; ++bj) { f32x4 v0 = acc[ai][bj][m][0], v1 = acc[ai][bj][m][1];
                        if (act == 1) { v0 = silu4(v0); v1 = silu4(v1); } else if (act == 2) { v0 = sig4(v0); v1 = sig4(v1); }
                        st_bf16x8(base + (size_t)row * ld + col0 + bj * 128 + c8, v0, v1); } }
        }
    }
};
struct EpiConvPw {
    static constexpr bool PERM = true;
    bf16_t* M1; const bf16_t* Gt; const float* bias;
    __device__ __forceinline__ void operator()(const f32x4 (&acc)[2][2][4][2], const pg8::Unit& u, int wr, int wc, int fr, int fq) const {
        const int row0 = u.pm * 256 + wr * 64 + fr, col0 = u.pn * 256 + wc * 32 + 8 * fq;
#pragma unroll
        for (int bj = 0; bj < 2; ++bj) { const int col = col0 + bj * 128;
            const f32x4 b0 = *(const f32x4*)(bias + col), b1 = *(const f32x4*)(bias + col + 4);
#pragma unroll
            for (int ai = 0; ai < 2; ++ai)
#pragma unroll
                for (int m = 0; m < 4; ++m) { const int row = row0 + ai * 128 + m * 16;
                    f32x4 g0, g1; ld_bf16x8(Gt + (size_t)row * (2 * DM) + col, g0, g1);
                    st_bf16x8(M1 + (size_t)row * DM + col, g0 * (acc[ai][bj][m][0] + b0), g1 * (acc[ai][bj][m][1] + b1)); } }
    }
};
struct EpiMerge {
    static constexpr bool PERM = true;
    bf16_t* M1; const bf16_t* Gt;
    __device__ __forceinline__ void operator()(const f32x4 (&acc)[2][2][4][2], const pg8::Unit& u, int wr, int wc, int fr, int fq) const {
        const int row0 = u.pm * 256 + wr * 64 + fr, col0 = u.pn * 256 + wc * 32 + 8 * fq;
#pragma unroll
        for (int ai = 0; ai < 2; ++ai)
#pragma unroll
            for (int m = 0; m < 4; ++m) { const int row = row0 + ai * 128 + m * 16;
#pragma unroll
                for (int bj = 0; bj < 2; ++bj) { const int col = col0 + bj * 128;
                    f32x4 g0, g1, p0, p1; ld_bf16x8(Gt + (size_t)row * (2 * DM) + DM + col, g0, g1); ld_bf16x8(M1 + (size_t)row * DM + col, p0, p1);
                    st_bf16x8(M1 + (size_t)row * DM + col, p0 + g0 * acc[ai][bj][m][0], p1 + g1 * acc[ai][bj][m][1]); } }
    }
};
struct EpiH {
    static constexpr bool PERM = false;
    const float* x; float* Hout; const float* mod;
    __device__ __forceinline__ void operator()(const f32x4 (&acc)[2][2][4][2], const pg8::Unit& u, int wr, int wc, int fr, int fq) const {
        const int row0 = u.pm * 256 + wr * 64 + fr, col0 = u.pn * 256 + wc * 32 + 4 * fq;
        const int b = (u.pm * 256) / SEQ;
        f32x4 ga[2][2];
#pragma unroll
        for (int bj = 0; bj < 2; ++bj)
#pragma unroll
            for (int n = 0; n < 2; ++n) ga[bj][n] = *(const f32x4*)(mod + (size_t)b * (NMOD * DM) + 2 * DM + col0 + bj * 128 + n * 16);
#pragma unroll
        for (int ai = 0; ai < 2; ++ai)
#pragma unroll
            for (int m = 0; m < 4; ++m) { const size_t off = (size_t)(row0 + ai * 128 + m * 16) * DM + col0;
#pragma unroll
                for (int bj = 0; bj < 2; ++bj)
#pragma unroll
                    for (int n = 0; n < 2; ++n) { const f32x4 xv = *(const f32x4*)(x + off + bj * 128 + n * 16);
                        *(f32x4*)(Hout + off + bj * 128 + n * 16) = xv + ga[bj][n] * acc[ai][bj][m][n]; } }
    }
};
struct EpiUp {
    static constexpr bool PERM = true;
    bf16_t* HID;
    __device__ __forceinline__ void operator()(const f32x4 (&acc)[2][2][4][2], const pg8::Unit& u, int wr, int wc, int fr, int fq) const {
        const int row0 = u.pm * 256 + wr * 64 + fr, col = u.pn * 128 + wc * 32 + 8 * fq;
#pragma unroll
        for (int ai = 0; ai < 2; ++ai)
#pragma unroll
            for (int m = 0; m < 4; ++m) { const int row = row0 + ai * 128 + m * 16;
                st_bf16x8(HID + (size_t)row * DE + col, silu4(acc[ai][0][m][0]) * acc[ai][1][m][0], silu4(acc[ai][0][m][1]) * acc[ai][1][m][1]); }
    }
};
struct EpiDown {
    static constexpr bool PERM = true;
    bf16_t* Y;
    __device__ __forceinline__ void operator()(const f32x4 (&acc)[2][2][4][2], const pg8::Unit& u, int wr, int wc, int fr, int fq) const {
        const int row0 = u.pm * 256 + wr * 64 + fr, col0 = u.pn * 256 + wc * 32 + 8 * fq;
#pragma unroll
        for (int ai = 0; ai < 2; ++ai)
#pragma unroll
            for (int m = 0; m < 4; ++m) { const int row = row0 + ai * 128 + m * 16;
#pragma unroll
                for (int bj = 0; bj < 2; ++bj) st_bf16x8(Y + (size_t)row * DM + col0 + bj * 128, acc[ai][bj][m][0], acc[ai][bj][m][1]); }
    }
};

struct MoeOrder {
    const LAS int* tstart; const LAS int* cnt; int G, c, NT;
    const char* A; const char* W; const int* lists; size_t wstride, astride_tile, wtile;
    bool gather;
    __device__ __forceinline__ bool next(int i, pg8::Unit& u) const {
        const int L = i * G + c; const int ntile = tstart[NE];
        if (L >= ntile * NT) return false;
        const int mt = L / NT, pn = L % NT;
        int e = 0;
#pragma unroll 1
        while (e < NE - 1 && tstart[e + 1] <= mt) ++e;
        const int lt = mt - tstart[e];
        u.pm = mt; u.pn = pn;
        u.pb = W + (size_t)e * wstride + (size_t)pn * wtile;
        if (gather) { u.pa = A; u.rows = lists + (size_t)e * T + lt * 256; const int rem = cnt[e] - lt * 256; u.nvalid = rem < 256 ? rem : 256; }
        else { u.pa = A + (size_t)mt * astride_tile; u.rows = nullptr; u.nvalid = 256; }
        return true;
    }
};

__device__ __forceinline__ void tr_item(const float* W, int ldw, int k0, int n0, bf16_t* D, int K, int drow0, float scale, LAS float* scr, int lane) {
#pragma unroll 8
    for (int i = 0; i < 32; ++i) { const int kk = 2 * i + (lane >> 5); scr[kk * 33 + (lane & 31)] = W[(size_t)(k0 + kk) * ldw + n0 + (lane & 31)]; }
    LDS_WAIT(); asm volatile("" ::: "memory");
    const int c = lane & 7;
#pragma unroll
    for (int j = 0; j < 4; ++j) { const int n = (lane >> 3) + 8 * j; const LAS float* s = scr + (8 * c) * 33 + n;
        u32x4 o; o.x = cvt_pk_bf16(s[0 * 33] * scale, s[1 * 33] * scale); o.y = cvt_pk_bf16(s[2 * 33] * scale, s[3 * 33] * scale);
        o.z = cvt_pk_bf16(s[4 * 33] * scale, s[5 * 33] * scale); o.w = cvt_pk_bf16(s[6 * 33] * scale, s[7 * 33] * scale);
        *(u32x4*)(D + (size_t)(drow0 + n) * K + k0 + 8 * c) = o; }
    LDS_WAIT(); asm volatile("" ::: "memory");
}
__device__ __forceinline__ void p0_prologue(Frame& F) {
    {
        LAS float* cact = (LAS float*)F.lds;
        LAS float* red = (LAS float*)(F.lds + 32768);
        const float* c = F.in[IN_C];
        for (int i = F.tid; i < BATCH * DM; i += NTHR) cact[i] = siluf_(c[i]);
        __syncthreads();
        float* mod = (float*)(F.ws + WS_MOD); float* modf = mod + BATCH * NMOD * DM;
        for (int cb = F.bid; cb < 256; cb += F.G) {
            const int j0 = cb * 32, col = F.tid & 31, kq = F.tid >> 5;
            const bool isf = j0 >= NMOD * DM;
            const float* W = isf ? F.in[IN_WADAF] : F.in[IN_WADA]; const int ldw = isf ? 2 * DM : NMOD * DM; const int jj = isf ? j0 - NMOD * DM : j0;
            float a[8];
#pragma unroll
            for (int b = 0; b < 8; ++b) a[b] = 0.f;
            for (int k = kq * 64; k < kq * 64 + 64; ++k) { const float w = W[(size_t)k * ldw + jj + col];
#pragma unroll
                for (int b = 0; b < 8; ++b) a[b] += cact[b * DM + k] * w; }
#pragma unroll
            for (int b = 0; b < 8; ++b) red[(kq * 8 + b) * 32 + col] = a[b];
            __syncthreads();
            if (F.tid < 256) { const int b = F.tid >> 5; float s = 0.f;
#pragma unroll
                for (int q = 0; q < 16; ++q) s += red[(q * 8 + b) * 32 + col];
                if (isf) modf[b * 2 * DM + jj + col] = s + F.in[IN_BADAF][jj + col]; else mod[b * NMOD * DM + jj + col] = s + F.in[IN_BADA][jj + col]; }
            __syncthreads();
        }
    }
    LAS float* scr = (LAS float*)(F.lds + F.wave * 16384);
    const int gw = F.bid * NWAVES + F.wave, NGW = F.G * NWAVES;
    constexpr int I_IN = (NPROJ / 32) * (DM / 64), I_PW = (DM / 32) * (CONV_DIM / 64), I_GO = (DM / 32) * (VD / 64), I_OUT = (DM / 32) * (DM / 64);
    constexpr int I_13E = (2 * DE / 32) * (DM / 64), I_2E = (DM / 32) * (DE / 64);
    constexpr int NITEMS = I_IN + I_PW + I_GO + I_OUT + NE * I_13E + NE * I_2E;
    for (int it = gw; it < NITEMS; it += NGW) {
        int r = it;
        if (r < I_IN) { const int nb = r / 16, kb = r % 16, d0 = nb * 32; int src; float sc = 1.f;
            if (d0 < 1024) { const int j = d0 >> 8, w = d0 & 255; src = (w < 128) ? (128 * j + w) : (512 + 128 * j + (w - 128)); }
            else if (d0 < 4096) { src = d0; if (d0 < 1536) sc = 0.08838834764831845f; }
            else src = d0 + 16;
            tr_item(F.in[IN_WIN], IN_DIM, kb * 64, src, (bf16_t*)(F.ws + WS_WIN), DM, d0, sc, scr, F.lane); continue; }
        r -= I_IN;
        if (r < I_PW) { const int nb = r / 8, kb = r % 8; tr_item(F.in[IN_WPW], DM, kb * 64, nb * 32, (bf16_t*)(F.ws + WS_WPW), CONV_DIM, nb * 32, 1.f, scr, F.lane); continue; }
        r -= I_PW;
        if (r < I_GO) { const int nb = r / 16, kb = r % 16; tr_item(F.in[IN_WGO], DM, kb * 64, nb * 32, (bf16_t*)(F.ws + WS_WGO), VD, nb * 32, 1.f, scr, F.lane); continue; }
        r -= I_GO;
        if (r < I_OUT) { const int nb = r / 16, kb = r % 16; tr_item(F.in[IN_WOUT], DM, kb * 64, nb * 32, (bf16_t*)(F.ws + WS_WOUT), DM, nb * 32, 1.f, scr, F.lane); continue; }
        r -= I_OUT;
        if (r < NE * I_13E) { const int e = r / I_13E, q = r % I_13E, nb = q / 16, kb = q % 16, d0 = nb * 32, p = d0 >> 8, w = d0 & 255;
            const float* src = (w < 128) ? F.in[IN_W1] : F.in[IN_W3]; const int scol = 128 * p + (w & 127);
            tr_item(src + (size_t)e * DM * DE, DE, kb * 64, scol, (bf16_t*)(F.ws + WS_W13) + (size_t)e * (2 * DE) * DM, DM, d0, 1.f, scr, F.lane); continue; }
        r -= NE * I_13E;
        { const int e = r / I_2E, q = r % I_2E, nb = q / 8, kb = q % 8;
            tr_item(F.in[IN_W2] + (size_t)e * DE * DM, DM, kb * 64, nb * 32, (bf16_t*)(F.ws + WS_W2) + (size_t)e * DM * DE, DE, nb * 32, 1.f, scr, F.lane); }
    }
}

__device__ __forceinline__ void p1a_norm(Frame& F) {
    LAS float* wa1 = (LAS float*)F.lds;
    LAS float* wa2 = (LAS float*)(F.lds + 65536);
    const float* win = F.in[IN_WIN];
    for (int i = F.tid; i < LOWRANK * DM; i += NTHR) { const int k = i >> 4, j = i & 15; wa1[j * DM + k] = win[(size_t)k * IN_DIM + 4096 + j]; }
    for (int i = F.tid; i < LOWRANK * QKD; i += NTHR) wa2[i] = F.in[IN_WA2][i];
    __syncthreads();
    const float* mod = (const float*)(F.ws + WS_MOD);
    bf16_t* U = (bf16_t*)(F.ws + WS_U); float* LG = (float*)(F.ws + WS_LG);
    const int gw = F.bid * NWAVES + F.wave, NGW = F.G * NWAVES, lane = F.lane;
    for (int row = gw; row < T; row += NGW) {
        const int b = row / SEQ;
        const f32x4* xr = (const f32x4*)(F.in[IN_X] + (size_t)row * DM) + lane;
        f32x4 v[4]; float ss = 0.f;
#pragma unroll
        for (int j = 0; j < 4; ++j) { v[j] = xr[64 * j]; ss += (v[j][0] * v[j][0] + v[j][1] * v[j][1]) + (v[j][2] * v[j][2] + v[j][3] * v[j][3]); }
        const float rinv = 1.0f / sqrtf(wave_sum(ss) * (1.0f / DM) + EPS);
        const float* sh = mod + (size_t)b * NMOD * DM; const float* sc = sh + DM;
#pragma unroll
        for (int j = 0; j < 4; ++j) { const int k = 4 * lane + 256 * j;
            const f32x4 g = *(const f32x4*)(F.in[IN_GN1] + k), s1 = *(const f32x4*)(sc + k), s0 = *(const f32x4*)(sh + k);
            v[j] = (v[j] * rinv * g) * (s1 + 1.0f) + s0; }
        u32x2* o8 = (u32x2*)(U + (size_t)row * DM) + lane;
#pragma unroll
        for (int j = 0; j < 4; ++j) { u32x2 w; w.x = cvt_pk_bf16(v[j][0], v[j][1]); w.y = cvt_pk_bf16(v[j][2], v[j][3]); o8[64 * j] = w; }
        float a1[LOWRANK];
#pragma unroll
        for (int i = 0; i < LOWRANK; ++i) { float s = 0.f;
#pragma unroll
            for (int j = 0; j < 4; ++j) { const f32x4 w = *(const LAS f32x4*)(wa1 + i * DM + 4 * lane + 256 * j); s += (v[j][0] * w[0] + v[j][1] * w[1]) + (v[j][2] * w[2] + v[j][3] * w[3]); }
            a1[i] = wave_sum(s); }
        f32x4 y0 = *(const f32x4*)(F.in[IN_BA2] + 8 * lane), y1 = *(const f32x4*)(F.in[IN_BA2] + 8 * lane + 4);
#pragma unroll
        for (int i = 0; i < LOWRANK; ++i) { const f32x4 w0 = *(const LAS f32x4*)(wa2 + i * QKD + 8 * lane), w1 = *(const LAS f32x4*)(wa2 + i * QKD + 8 * lane + 4); y0 += w0 * a1[i]; y1 += w1 * a1[i]; }
        f32x4 l0, l1;
#pragma unroll
        for (int q = 0; q < 4; ++q) { const float a = y0[q], c = y1[q];
            l0[q] = (fminf(a, 0.f) - log1pf(__expf(-fabsf(a)))) * (1.0f / 16.0f); l1[q] = (fminf(c, 0.f) - log1pf(__expf(-fabsf(c)))) * (1.0f / 16.0f); }
        f32x4* lo = (f32x4*)(LG + (size_t)row * QKD + 8 * lane); lo[0] = l0; lo[1] = l1;
    }
}

__device__ __forceinline__ void p2_scan_naive(Frame& F) {
    LAS float* qs = (LAS float*)F.lds;
    LAS float* ks = qs + 32 * 128;
    LAS float* es = ks + 32 * 128;
    LAS float* vs = es + 32 * 128;
    LAS float* po = vs + 32 * 32;
    const bf16_t* Q = (const bf16_t*)(F.ws + WS_Q); const bf16_t* Kb = (const bf16_t*)(F.ws + WS_K); bf16_t* V = (bf16_t*)(F.ws + WS_V); const float* LG = (const float*)(F.ws + WS_LG);
    const int e = F.tid & 31, dg = F.tid >> 5;
    for (int item = F.bid; item < BATCH * NH * 8; item += F.G) {
        const int sl = item & 7, h = (item >> 3) & 3, b = item >> 5;
        float S[8];
#pragma unroll
        for (int i = 0; i < 8; ++i) S[i] = 0.f;
        for (int t0 = 0; t0 < SEQ; t0 += 32) {
            const size_t rowb = (size_t)b * SEQ + t0;
            for (int i = F.tid; i < 32 * 128; i += NTHR) { const int t = i >> 7, d = i & 127;
                qs[i] = bf2f(Q[(rowb + t) * QKD + h * DK + d]); ks[i] = bf2f(Kb[(rowb + t) * QKD + h * DK + d]); es[i] = __expf(LG[(rowb + t) * QKD + h * DK + d]); }
            for (int i = F.tid; i < 32 * 32; i += NTHR) { const int t = i >> 5, ee = i & 31; vs[i] = bf2f(V[(rowb + t) * VD + h * DV + sl * 32 + ee]); }
            __syncthreads();
            for (int t = 0; t < 32; ++t) { const float vv = vs[t * 32 + e]; float p = 0.f;
#pragma unroll
                for (int i = 0; i < 8; ++i) { const int d = dg * 8 + i; S[i] = es[t * 128 + d] * S[i] + ks[t * 128 + d] * vv; p += qs[t * 128 + d] * S[i]; }
                po[(t * 16 + dg) * 32 + e] = p; }
            __syncthreads();
            for (int i = F.tid; i < 32 * 32; i += NTHR) { const int t = i >> 5, ee = i & 31; float s = 0.f;
#pragma unroll
                for (int q = 0; q < 16; ++q) s += po[(t * 16 + q) * 32 + ee];
                V[(rowb + t) * VD + h * DV + sl * 32 + ee] = (bf16_t)(cvt_pk_bf16(s, 0.f) & 0xffffu); }
            __syncthreads();
        }
    }
}

__device__ __forceinline__ void p2_conv(Frame& F) {
    constexpr int TT = 32, HALO = CONV_W - 1, ROWS = TT + HALO;
    LAS bf16_t* zt = (LAS bf16_t*)F.lds;
    LAS float* wd = (LAS float*)(F.lds + 65536);
    for (int i = F.tid; i < CONV_W * CONV_DIM; i += NTHR) wd[i] = F.in[IN_WDW][i];
    const bf16_t* Z = (const bf16_t*)(F.ws + WS_Z); bf16_t* Z2 = (bf16_t*)(F.ws + WS_Z2);
    const int lane = F.lane, ch = 8 * lane;
    f32x4 bd0 = *(const f32x4*)(F.in[IN_BDW] + ch), bd1 = *(const f32x4*)(F.in[IN_BDW] + ch + 4);
    f32x4 lg0 = *(const f32x4*)(F.in[IN_GCLN] + ch), lg1 = *(const f32x4*)(F.in[IN_GCLN] + ch + 4);
    f32x4 lb0 = *(const f32x4*)(F.in[IN_BCLN] + ch), lb1 = *(const f32x4*)(F.in[IN_BCLN] + ch + 4);
    for (int tile = F.bid; tile < T / TT; tile += F.G) {
        const int t0 = tile * TT, s0 = t0 % SEQ;
        __syncthreads();
        for (int i = F.tid; i < ROWS * 64; i += NTHR) { const int r = i >> 6, c8 = i & 63; const int s = s0 - HALO + r;
            u32x4 w = (u32x4){0u, 0u, 0u, 0u};
            if (s >= 0) w = *(const u32x4*)(Z + (size_t)(t0 - HALO + r) * CONV_DIM + c8 * 8);
            *(LAS u32x4*)(zt + r * CONV_DIM + c8 * 8) = w; }
        __syncthreads();
        for (int i = 0; i < TT / NWAVES; ++i) { const int tt = F.wave * (TT / NWAVES) + i;
            f32x4 a0 = bd0, a1 = bd1;
#pragma unroll
            for (int j = 0; j < CONV_W; ++j) { const u32x4 zw = *(const LAS u32x4*)(zt + (tt + j) * CONV_DIM + ch);
                const f32x4 w0 = *(const LAS f32x4*)(wd + j * CONV_DIM + ch), w1 = *(const LAS f32x4*)(wd + j * CONV_DIM + ch + 4);
                a0 += (f32x4){bflo(zw.x), bfhi(zw.x), bflo(zw.y), bfhi(zw.y)} * w0; a1 += (f32x4){bflo(zw.z), bfhi(zw.z), bflo(zw.w), bfhi(zw.w)} * w1; }
            float s = (a0[0] + a0[1]) + (a0[2] + a0[3]) + (a1[0] + a1[1]) + (a1[2] + a1[3]);
            const float mean = wave_sum(s) * (1.0f / CONV_DIM);
            a0 -= mean; a1 -= mean;
            float q = (a0[0] * a0[0] + a0[1] * a0[1]) + (a0[2] * a0[2] + a0[3] * a0[3]) + (a1[0] * a1[0] + a1[1] * a1[1]) + (a1[2] * a1[2] + a1[3] * a1[3]);
            const float rstd = 1.0f / sqrtf(wave_sum(q) * (1.0f / CONV_DIM) + EPS);
            a0 = a0 * rstd * lg0 + lb0; a1 = a1 * rstd * lg1 + lb1;
            st_bf16x8(Z2 + (size_t)(t0 + tt) * CONV_DIM + ch, silu4(a0), silu4(a1)); }
    }
    __syncthreads();
}

__device__ __forceinline__ void p2c_gate(Frame& F) {
    const bf16_t* O = (const bf16_t*)(F.ws + WS_V); bf16_t* RS = (bf16_t*)(F.ws + WS_RS);
    const int gw = F.bid * NWAVES + F.wave, NGW = F.G * NWAVES, lane = F.lane;
    f32x4 g[4];
#pragma unroll
    for (int j = 0; j < 4; ++j) g[j] = *(const f32x4*)(F.in[IN_GGLA] + 16 * lane + 4 * j);
    for (int row = gw; row < T; row += NGW) {
        f32x4 o[4], r[4];
        ld_bf16x8(O + (size_t)row * VD + 16 * lane, o[0], o[1]); ld_bf16x8(O + (size_t)row * VD + 16 * lane + 8, o[2], o[3]);
        ld_bf16x8(RS + (size_t)row * VD + 16 * lane, r[0], r[1]); ld_bf16x8(RS + (size_t)row * VD + 16 * lane + 8, r[2], r[3]);
        float ss = 0.f;
#pragma unroll
        for (int j = 0; j < 4; ++j) ss += (o[j][0] * o[j][0] + o[j][1] * o[j][1]) + (o[j][2] * o[j][2] + o[j][3] * o[j][3]);
        ss += __shfl_xor(ss, 1); ss += __shfl_xor(ss, 2); ss += __shfl_xor(ss, 4); ss += __shfl_xor(ss, 8);
        const float rinv = 1.0f / sqrtf(ss * (1.0f / DV) + EPS);
#pragma unroll
        for (int j = 0; j < 4; ++j) o[j] = (o[j] * rinv * g[j]) * r[j];
        st_bf16x8(RS + (size_t)row * VD + 16 * lane, o[0], o[1]); st_bf16x8(RS + (size_t)row * VD + 16 * lane + 8, o[2], o[3]);
    }
}

__device__ __forceinline__ void p5_router(Frame& F) {
    LAS float* wr = (LAS float*)F.lds;
    for (int i = F.tid; i < NGRP * DM; i += NTHR) { const int k = i >> 2, j = i & 3; wr[j * DM + k] = F.in[IN_WRG][i]; }
    for (int i = F.tid; i < NE * DM; i += NTHR) { const int k = i >> 5, j = i & 31; wr[(NGRP + j) * DM + k] = F.in[IN_WRE][i]; }
    __syncthreads();
    const float* mod = (const float*)(F.ws + WS_MOD);
    const float* Hh = F.out; bf16_t* U2 = (bf16_t*)(F.ws + WS_Q);
    int* lists = (int*)(F.ws + WS_LIST); int* tok = (int*)(F.ws + WS_TOK);
    const int gw = F.bid * NWAVES + F.wave, NGW = F.G * NWAVES, lane = F.lane;
    for (int row = gw; row < T; row += NGW) {
        const int b = row / SEQ;
        const f32x4* xr = (const f32x4*)(Hh + (size_t)row * DM) + lane;
        f32x4 v[4]; float ss = 0.f;
#pragma unroll
        for (int j = 0; j < 4; ++j) { v[j] = xr[64 * j]; ss += (v[j][0] * v[j][0] + v[j][1] * v[j][1]) + (v[j][2] * v[j][2] + v[j][3] * v[j][3]); }
        const float rinv = 1.0f / sqrtf(wave_sum(ss) * (1.0f / DM) + EPS);
        const float* sh = mod + (size_t)b * NMOD * DM + 3 * DM; const float* sc = sh + DM;
#pragma unroll
        for (int j = 0; j < 4; ++j) { const int k = 4 * lane + 256 * j;
            const f32x4 g = *(const f32x4*)(F.in[IN_GN2] + k), s1 = *(const f32x4*)(sc + k), s0 = *(const f32x4*)(sh + k);
            v[j] = (v[j] * rinv * g) * (s1 + 1.0f) + s0; }
        u32x2* o8 = (u32x2*)(U2 + (size_t)row * DM) + lane;
#pragma unroll
        for (int j = 0; j < 4; ++j) { u32x2 w; w.x = cvt_pk_bf16(v[j][0], v[j][1]); w.y = cvt_pk_bf16(v[j][2], v[j][3]); o8[64 * j] = w; }
        float lg[NGRP + NE];
#pragma unroll
        for (int i = 0; i < NGRP + NE; ++i) { float s = 0.f;
#pragma unroll
            for (int j = 0; j < 4; ++j) { const f32x4 w = *(const LAS f32x4*)(wr + i * DM + 4 * lane + 256 * j); s += (v[j][0] * w[0] + v[j][1] * w[1]) + (v[j][2] * w[2] + v[j][3] * w[3]); }
            lg[i] = wave_sum(s); }
        float gl[NGRP]; int gsel = 0;
#pragma unroll
        for (int j = 0; j < NGRP; ++j) gl[j] = lg[j] + F.in[IN_BRG][j];
        float gmax = gl[0];
#pragma unroll
        for (int j = 1; j < NGRP; ++j) if (gl[j] > gmax) { gmax = gl[j]; gsel = j; }
        float den = 0.f;
#pragma unroll
        for (int j = 0; j < NGRP; ++j) den += __expf(gl[j] - gmax);
        const float wg = 1.0f / den;
        float le[EPG];
#pragma unroll
        for (int j = 0; j < EPG; ++j) { float x = 0.f;
#pragma unroll
            for (int g2 = 0; g2 < NGRP; ++g2) x = (gsel == g2) ? (lg[NGRP + g2 * EPG + j] + F.in[IN_BRE][g2 * EPG + j]) : x;
            le[j] = x; }
        int i0 = 0; float v0 = le[0];
#pragma unroll
        for (int j = 1; j < EPG; ++j) if (le[j] > v0) { v0 = le[j]; i0 = j; }
        int i1 = -1; float v1 = -3.0e38f;
#pragma unroll
        for (int j = 0; j < EPG; ++j) if (j != i0 && le[j] > v1) { v1 = le[j]; i1 = j; }
        const float e1 = __expf(v1 - v0); const float w0 = wg / (1.0f + e1), w1 = wg * e1 / (1.0f + e1);
        const int eid0 = gsel * EPG + i0, eid1 = gsel * EPG + i1;
        if (lane == 0) {
            const int r0 = (int)atomicAdd(F.ctl + CW_CNT + eid0, 1u), r1 = (int)atomicAdd(F.ctl + CW_CNT + eid1, 1u);
            lists[(size_t)eid0 * T + r0] = row; lists[(size_t)eid1 * T + r1] = row;
            int* ti = tok + (size_t)row * 8; ti[0] = eid0; ti[1] = r0; ti[2] = __float_as_int(w0); ti[3] = eid1; ti[4] = r1; ti[5] = __float_as_int(w1);
        }
    }
    __syncthreads();
}

__device__ __forceinline__ void moe_table(Frame& F, LAS int* tbl) {
    if (F.tid == 0) { int acc = 0;
        for (int e = 0; e < NE; ++e) { const int c = (int)__hip_atomic_load(F.ctl + CW_CNT + e, __ATOMIC_RELAXED, __HIP_MEMORY_SCOPE_AGENT); tbl[e] = acc; tbl[40 + e] = c; acc += (c + 255) >> 8; }
        tbl[NE] = acc; }
    __syncthreads();
}

__device__ __forceinline__ void p8_final(Frame& F) {
    LAS int* tbl = (LAS int*)(F.lds + TBL_OFF);
    moe_table(F, tbl);
    const float* mod = (const float*)(F.ws + WS_MOD); const float* modf = mod + BATCH * NMOD * DM;
    const bf16_t* Y = (const bf16_t*)(F.ws + WS_Y); const int* tok = (const int*)(F.ws + WS_TOK);
    const int gw = F.bid * NWAVES + F.wave, NGW = F.G * NWAVES, lane = F.lane;
    for (int row = gw; row < T; row += NGW) {
        const int b = row / SEQ;
        const int* ti = tok + (size_t)row * 8;
        const int e0 = ti[0], r0 = ti[1], e1 = ti[3], r1 = ti[4]; const float w0 = __int_as_float(ti[2]), w1 = __int_as_float(ti[5]);
        const size_t s0 = (size_t)tbl[e0] * 256 + r0, s1 = (size_t)tbl[e1] * 256 + r1;
        const f32x4* hr = (const f32x4*)(F.out + (size_t)row * DM) + lane;
        const u32x2* y0 = (const u32x2*)(Y + s0 * DM) + lane; const u32x2* y1 = (const u32x2*)(Y + s1 * DM) + lane;
        const float* ga = mod + (size_t)b * NMOD * DM + 5 * DM;
        f32x4 v[4]; float ss = 0.f;
#pragma unroll
        for (int j = 0; j < 4; ++j) { const int k = 4 * lane + 256 * j; const u32x2 a = y0[64 * j], c = y1[64 * j];
            const f32x4 ya = (f32x4){bflo(a.x), bfhi(a.x), bflo(a.y), bfhi(a.y)}, yc = (f32x4){bflo(c.x), bfhi(c.x), bflo(c.y), bfhi(c.y)};
            v[j] = hr[64 * j] + *(const f32x4*)(ga + k) * (ya * w0 + yc * w1);
            ss += (v[j][0] * v[j][0] + v[j][1] * v[j][1]) + (v[j][2] * v[j][2] + v[j][3] * v[j][3]); }
        const float rinv = 1.0f / sqrtf(wave_sum(ss) * (1.0f / DM) + EPS);
        const float* sh = modf + (size_t)b * 2 * DM; const float* sc = sh + DM;
        f32x4* orow = (f32x4*)(F.out + (size_t)row * DM) + lane;
#pragma unroll
        for (int j = 0; j < 4; ++j) { const int k = 4 * lane + 256 * j;
            const f32x4 g = *(const f32x4*)(F.in[IN_GFIN] + k), s1v = *(const f32x4*)(sc + k), s0v = *(const f32x4*)(sh + k);
            orow[64 * j] = (v[j] * rinv * g) * (s1v + 1.0f) + s0v; }
    }
}

constexpr int NPHASE = 11;
struct Args { const float* in[28]; float* out; unsigned char* ws; int ph_lo, ph_hi; };
__global__ void __launch_bounds__(NTHR, 2) fwd_kernel(Args args) {
    extern __shared__ __attribute__((aligned(16))) unsigned char lds[];
    Frame F;
    F.lds = (LAS unsigned char*)lds;
    F.MISC = (volatile LAS unsigned*)(F.lds + MISC_OFF);
    F.tid = threadIdx.x; F.lane = F.tid & 63; F.wave = __builtin_amdgcn_readfirstlane(F.tid >> 6);
    F.G = gridDim.x; F.bid = blockIdx.x;
    F.ws = args.ws; F.out = args.out; F.ctl = (unsigned*)(args.ws + WS_CTL);
#pragma unroll
    for (int i = 0; i < 28; ++i) F.in[i] = args.in[i];
    if (F.tid < 128) F.MISC[F.tid] = 0u;
    __syncthreads();
    const int lo = args.ph_lo, hi = args.ph_hi;
    XcdBarrier bar; bar.bar = F.ctl + CW_BAR; bar.x = 0; bar.st = nullptr;
    if (hi - lo > 1) bar = xcd_barrier_post(F.ctl + CW_BAR, F.MISC + 8);
#define IN(k) (lo <= (k) && (k) < hi)
#define SEAM(k) do { if (IN(k) && IN((k) + 1)) xcd_barrier(bar); } while (0)
    LAS unsigned char* ring = F.lds;

    if (IN(0)) { p0_prologue(F); } SEAM(0);
    if (IN(1)) { p1a_norm(F); } SEAM(1);
    if (IN(2)) {
        pg8::DenseOrder S; S.init(F.ws + WS_U, F.ws + WS_WIN, T, NPROJ, DM, F.G, F.bid);
        EpiProj E{F.ws, (unsigned char*)F.out};
        pg8::gemm_phase<EpiProj, pg8::DenseOrder, false>(ring, DM, S, E);
    } SEAM(2);
    if (IN(3)) { p2_scan_naive(F); p2_conv(F); } SEAM(3);
    if (IN(4)) {
        p2c_gate(F);
        __syncthreads();
        pg8::DenseOrder S; S.init(F.ws + WS_Z2, F.ws + WS_WPW, T, DM, CONV_DIM, F.G, F.bid);
        EpiConvPw E{(bf16_t*)(F.ws + WS_U), (const bf16_t*)F.out, F.in[IN_BPW]};
        pg8::gemm_phase<EpiConvPw, pg8::DenseOrder, false>(ring, CONV_DIM, S, E);
    } SEAM(4);
    if (IN(5)) {
        pg8::DenseOrder S; S.init(F.ws + WS_RS, F.ws + WS_WGO, T, DM, VD, F.G, F.bid);
        EpiMerge E{(bf16_t*)(F.ws + WS_U), (const bf16_t*)F.out};
        pg8::gemm_phase<EpiMerge, pg8::DenseOrder, false>(ring, VD, S, E);
    } SEAM(5);
    if (IN(6)) {
        pg8::DenseOrder S; S.init(F.ws + WS_U, F.ws + WS_WOUT, T, DM, DM, F.G, F.bid);
        EpiH E{F.in[IN_X], F.out, (const float*)(F.ws + WS_MOD)};
        pg8::gemm_phase<EpiH, pg8::DenseOrder, false>(ring, DM, S, E);
    } SEAM(6);
    if (IN(7)) { p5_router(F); } SEAM(7);
    if (IN(8)) {
        LAS int* tbl = (LAS int*)(F.lds + TBL_OFF);
        moe_table(F, tbl);
        MoeOrder S; S.tstart = tbl; S.cnt = tbl + 40; S.G = F.G; S.c = F.bid; S.NT = 4; S.A = (const char*)(F.ws + WS_Q); S.W = (const char*)(F.ws + WS_W13);
        S.lists = (const int*)(F.ws + WS_LIST); S.wstride = (size_t)(2 * DE) * DM * 2; S.astride_tile = 0; S.wtile = (size_t)256 * DM * 2; S.gather = true;
        EpiUp E{(bf16_t*)(F.ws + WS_HID)};
        pg8::gemm_phase<EpiUp, MoeOrder, true>(ring, DM, S, E);
    } SEAM(8);
    if (IN(9)) {
        LAS int* tbl = (LAS int*)(F.lds + TBL_OFF);
        moe_table(F, tbl);
        MoeOrder S; S.tstart = tbl; S.cnt = tbl + 40; S.G = F.G; S.c = F.bid; S.NT = 4; S.A = (const char*)(F.ws + WS_HID); S.W = (const char*)(F.ws + WS_W2);
        S.lists = nullptr; S.wstride = (size_t)DM * DE * 2; S.astride_tile = (size_t)256 * DE * 2; S.wtile = (size_t)256 * DE * 2; S.gather = false;
        EpiDown E{(bf16_t*)(F.ws + WS_Y)};
        pg8::gemm_phase<EpiDown, MoeOrder, false>(ring, DE, S, E);
    } SEAM(9);
    if (IN(10)) { p8_final(F); }
#undef IN
#undef SEAM
}

extern "C" void kernel_launch(void* const* d_in, const int* in_sizes, int n_in, void* d_out, int out_size, void* d_ws, size_t ws_size, hipStream_t stream) {
    static int grid = 0;
    if (grid == 0) {
        if (n_in != 28 || in_sizes[0] != T * DM || out_size != T * DM || ws_size < WS_END) {
            fprintf(stderr, "kernel_launch: shape / workspace mismatch (n_in %d, in0 %d, out %d, ws %zu, need %zu)\n", n_in, n_in > 0 ? in_sizes[0] : -1, out_size, ws_size, (size_t)WS_END); grid = -1; return; }
        int dev = 0, cus = 0, per_cu = 0;
        if (hipGetDevice(&dev) != hipSuccess || hipDeviceGetAttribute(&cus, hipDeviceAttributeMultiprocessorCount, dev) != hipSuccess) { grid = -1; return; }
        if (hipFuncSetAttribute((const void*)fwd_kernel, hipFuncAttributeMaxDynamicSharedMemorySize, LDS_BYTES) != hipSuccess) { fprintf(stderr, "kernel_launch: hipFuncSetAttribute failed\n"); grid = -1; return; }
        if (hipOccupancyMaxActiveBlocksPerMultiprocessor(&per_cu, (const void*)fwd_kernel, NTHR, LDS_BYTES) != hipSuccess || per_cu < 1) {
            fprintf(stderr, "kernel_launch: occupancy query reports %d workgroups per CU\n", per_cu); (void)hipGetLastError(); grid = -1; return; }
        grid = cus;
    }
    if (grid < 0) return;
    if (hipMemsetAsync((char*)d_ws + WS_CTL, 0, CTL_ZERO_BYTES, stream) != hipSuccess) return;
    Args a{};
    for (int i = 0; i < 28; ++i) a.in[i] = (const float*)d_in[i];
    a.out = (float*)d_out; a.ws = (unsigned char*)d_ws;
#if MK_N_LAUNCHES == 1
    a.ph_lo = 0; a.ph_hi = NPHASE;
    hipLaunchKernelGGL(fwd_kernel, dim3(grid), dim3(NTHR), LDS_BYTES, stream, a);
#else
    for (int p = 0; p < NPHASE; ++p) { a.ph_lo = p; a.ph_hi = p + 1; hipLaunchKernelGGL(fwd_kernel, dim3(grid), dim3(NTHR), LDS_BYTES, stream, a); }
#endif
}
```

```cpp
#include <hip/hip_runtime.h>
#include <cstdio>
#include <cstdint>

#ifndef MK_N_LAUNCHES
#define MK_N_LAUNCHES 1
#endif

#ifndef DIAG_A
#define DIAG_A -2
#endif
#ifndef DIAG_B
#define DIAG_B -1
#endif
#ifndef DIAG_R
#define DIAG_R -1
#endif
#define LAS __attribute__((address_space(3)))
#define GAS __attribute__((address_space(1)))
typedef unsigned short bf16_t;
typedef short bf16x8 __attribute__((ext_vector_type(8)));
typedef float f32x4 __attribute__((ext_vector_type(4)));
typedef float f32x2 __attribute__((ext_vector_type(2)));
typedef unsigned u32x4 __attribute__((ext_vector_type(4)));
typedef unsigned u32x2 __attribute__((ext_vector_type(2)));

constexpr int BATCH = 8, SEQ = 2048, DM = 1024, T = BATCH * SEQ;
constexpr int CONV_DIM = 512, CONV_W = 31, NH = 4, DK = 128, DV = 256, LOWRANK = 16, QKD = 512, VD = 1024;
constexpr int NE = 32, NGRP = 4, EPG = 8, DE = 512, NMOD = 6;
constexpr int IN_DIM = 6160, NPROJ = 6144;
constexpr float EPS = 1e-6f;
constexpr int SLOT_CAP = 2 * T + NE * 256;

constexpr size_t MiB = 1u << 20;
constexpr size_t WS_CTL = 0, CTL_ZERO_BYTES = 1 * MiB;
constexpr size_t WS_MOD = 1 * MiB;
constexpr size_t WS_WRT = WS_MOD + 256 * 1024;
constexpr size_t WS_WA1T = WS_MOD + 512 * 1024;
constexpr size_t WS_LIST = 2 * MiB;
constexpr size_t WS_TOK = 4 * MiB;
constexpr size_t WS_WPW = 5 * MiB, WS_WGO = 6 * MiB, WS_WOUT = 8 * MiB, WS_WIN = 10 * MiB;
constexpr size_t WS_W13 = 22 * MiB, WS_W2 = 86 * MiB;
constexpr size_t WS_U = 118 * MiB;
constexpr size_t WS_Q = 150 * MiB, WS_K = 166 * MiB;
constexpr size_t WS_V = 182 * MiB;
constexpr size_t WS_RS = 214 * MiB;
constexpr size_t WS_LG = 246 * MiB;
constexpr size_t WS_Z = 278 * MiB, WS_Z2 = 294 * MiB;
constexpr size_t WS_HID = WS_V;
constexpr size_t WS_Y = 222 * MiB;
constexpr size_t WS_END = 310 * MiB;
constexpr int CW_CNT = 64;
constexpr int CW_BAR = 4096;

constexpr int LDS_BYTES = 163840;
constexpr int RING_BYTES = 131072;
constexpr int MISC_OFF = LDS_BYTES - 512;
constexpr int TBL_OFF = RING_BYTES;

constexpr int NWAVES = 8, NTHR = 512;

__device__ __forceinline__ unsigned cvt_pk_bf16(float lo, float hi) { unsigned r; asm volatile("v_cvt_pk_bf16_f32 %0, %1, %2" : "=v"(r) : "v"(lo), "v"(hi)); return r; }
typedef __bf16 bf16x2_t __attribute__((ext_vector_type(2)));
__device__ __forceinline__ unsigned cvt_pk_bf16_c(float lo, float hi) { const f32x2 v = {lo, hi}; const bf16x2_t b = __builtin_convertvector(v, bf16x2_t); return __builtin_bit_cast(unsigned, b); }
__device__ __forceinline__ float bf2f(unsigned short b) { return __uint_as_float(((unsigned)b) << 16); }
__device__ __forceinline__ float bflo(unsigned w) { return __uint_as_float(w << 16); }
__device__ __forceinline__ float bfhi(unsigned w) { return __uint_as_float(w & 0xffff0000u); }
__device__ __forceinline__ float sigmoidf_(float x) { return __builtin_amdgcn_rcpf(1.0f + __expf(-x)); }
__device__ __forceinline__ float siluf_(float x) { return x * sigmoidf_(x); }
template <int CTRL, int RMASK> __device__ __forceinline__ float dpp_mov0(float v) { return __int_as_float(__builtin_amdgcn_update_dpp(0, __float_as_int(v), CTRL, RMASK, 0xf, false)); }
__device__ __forceinline__ float wave_red63(float v) {
    v += dpp_mov0<0x111, 0xf>(v); v += dpp_mov0<0x112, 0xf>(v); v += dpp_mov0<0x114, 0xf>(v); v += dpp_mov0<0x118, 0xf>(v);
    v += dpp_mov0<0x142, 0xa>(v); v += dpp_mov0<0x143, 0xc>(v); return v;
}
__device__ __forceinline__ float wave_sum(float v) { return __int_as_float(__builtin_amdgcn_readlane(__float_as_int(wave_red63(v)), 63)); }
__device__ __forceinline__ float rsqf_(float x) { return __builtin_amdgcn_rsqf(x); }
#define LDS_WAIT() asm volatile("s_waitcnt lgkmcnt(0)" ::: "memory")
#define VM_WAIT() asm volatile("s_waitcnt vmcnt(0)" ::: "memory")

namespace pg8 {
constexpr int BM = 256, BK = 64, HALF = 128, HTB = HALF * BK * 2, STAGE_BYTES = 8 * HTB, NXCD = 8, WGM = 8;
__host__ __device__ __forceinline__ int lds_byte(int r, int c) { const int st = (r >> 4) * 2 + (c >> 5), rr = r & 15, cc = c & 31, ob = rr * 64 + cc * 2; return st * 1024 + (ob ^ (((ob >> 9) & 1) << 5)); }
__host__ __device__ __forceinline__ void stage_rc(int b, int& R, int& C) { const int st = b / 1024, sb = b % 1024, swz = sb ^ (((sb >> 9) & 1) << 5); R = (st >> 1) * 16 + swz / 64; C = (st & 1) * 32 + (swz % 64) / 2; }
__host__ __device__ __forceinline__ int perm32(int rho) { const int n = rho >> 4, i = rho & 15; return 8 * (i >> 2) + 4 * n + (i & 3); }

struct Unit { int pm, pn; const char* pa; const char* pb; const int* rows; int nvalid; };

struct DenseOrder {
    const char* A; const char* Bt; int K, nM, nN, nwg, G, c;
    __device__ __forceinline__ void init(const void* A_, const void* Bt_, int M, int N, int K_, int G_, int c_) { A = (const char*)A_; Bt = (const char*)Bt_; K = K_; nM = M / BM; nN = N / BM; nwg = nM * nN; G = G_; c = c_; }
    __device__ __forceinline__ bool next(int i, Unit& u) const {
        const long L = (long)i * G + c; if (L >= nwg) return false;
        int wgid = (int)L; { const int q = nwg / NXCD, r = nwg % NXCD, xcd = wgid % NXCD, off = wgid / NXCD; wgid = (xcd < r ? xcd * (q + 1) : r * (q + 1) + (xcd - r) * q) + off; }
        const int nig = WGM * nN, gid = wgid / nig, fm = gid * WGM, gsz = (nM - fm) < WGM ? (nM - fm) : WGM;
        u.pm = fm + ((wgid % nig) % gsz); u.pn = (wgid % nig) / gsz;
        u.pa = A + (size_t)u.pm * BM * K * 2; u.pb = Bt + (size_t)u.pn * BM * K * 2; u.rows = nullptr; u.nvalid = 256; return true;
    }
};

template <class Epi, class Sched, bool GATHER>
__device__ __forceinline__ void gemm_phase(LAS unsigned char* lds, const int K, const Sched& S, const Epi& E) {
    const int tid = threadIdx.x, wid = __builtin_amdgcn_readfirstlane(tid >> 6), lane = tid & 63, wr = wid >> 2, wc = wid & 3, fr = lane & 15, fq = lane >> 4;
    const int nt = K / BK;
    unsigned voffA[2], voffB[2]; int rA[2]; unsigned cA2[2];
#pragma unroll
    for (int i = 0; i < 2; ++i) { int R, C; stage_rc(tid * 16 + i * 8192, R, C); const int Rb = Epi::PERM ? ((R & ~31) + perm32(R & 31)) : R;
        voffA[i] = (unsigned)(R * K + C) * 2u; voffB[i] = (unsigned)(Rb * K + C) * 2u; rA[i] = R; cA2[i] = (unsigned)C * 2u; }
    unsigned voffG[2][2] = {{0u, 0u}, {0u, 0u}}, voffGn[2][2] = {{0u, 0u}, {0u, 0u}};
    const size_t kstep = (size_t)(BK * 2);
    const size_t hstep = (size_t)HALF * K * 2;
    const unsigned ldsw = (unsigned)wid * 1024u;
    const int aoff = lds_byte(wr * 64 + fr, fq * 8), boff = lds_byte(wc * 32 + fr, fq * 8);
#define PG8_SA(b, h) (((b) * 2 + (h)) * HTB)
#define PG8_SB(b, h) ((4 + (b) * 2 + (h)) * HTB)
#define PG8_STAGE(bufoff, gbase, voff) do { _Pragma("unroll") for (int _i = 0; _i < 2; ++_i) \
        __builtin_amdgcn_global_load_lds((const unsigned*)((const char*)(gbase) + (voff)[_i]), (LAS unsigned*)(lds + (bufoff) + ldsw + _i * 8192), 16, 0, 0); } while (0)
#define PG8_STAGE_A(bufoff, kptr, h) do { if constexpr (GATHER) { PG8_STAGE(bufoff, kptr, voffG[h]); } else { PG8_STAGE(bufoff, (kptr) + (h) * hstep, voffA); } } while (0)
#define PG8_LDA(dst, b, h) do { _Pragma("unroll") for (int m = 0; m < 4; ++m) _Pragma("unroll") for (int k = 0; k < 2; ++k) dst[m][k] = *(const LAS bf16x8*)(lds + PG8_SA(b, h) + aoff + m * 2048 + k * 1024); } while (0)
#define PG8_LDB(dst, b, h) do { _Pragma("unroll") for (int n = 0; n < 2; ++n) _Pragma("unroll") for (int k = 0; k < 2; ++k) dst[n][k] = *(const LAS bf16x8*)(lds + PG8_SB(b, h) + boff + n * 2048 + k * 1024); } while (0)
#define PG8_MMA(ai, bj, At, Bt) do { __builtin_amdgcn_s_setprio(1); _Pragma("unroll") for (int m = 0; m < 4; ++m) _Pragma("unroll") for (int n = 0; n < 2; ++n) _Pragma("unroll") for (int k = 0; k < 2; ++k) \
        acc[ai][bj][m][n] = __builtin_amdgcn_mfma_f32_16x16x32_bf16(Bt[n][k], At[m][k], acc[ai][bj][m][n], 0, 0, 0); __builtin_amdgcn_s_setprio(0); } while (0)
#define PG8_WAIT_V(n) asm volatile("s_waitcnt vmcnt(" #n ")" ::: "memory")
#define PG8_WAIT_L(n) asm volatile("s_waitcnt lgkmcnt(" #n ")" ::: "memory")
#define PG8_BAR __builtin_amdgcn_s_barrier()
#define PG8_SCHED __builtin_amdgcn_sched_barrier(0)
#define PG8_LOADROWS(dst, u) do { _Pragma("unroll") for (int _h = 0; _h < 2; ++_h) _Pragma("unroll") for (int _i = 0; _i < 2; ++_i) { const int _r = _h * HALF + rA[_i]; \
        const int _idx = (_r < (u).nvalid) ? (u).rows[_r] : 0; dst[_h][_i] = (unsigned)_idx * (unsigned)(K * 2) + cA2[_i]; } } while (0)
    Unit cur, nxt; int ui = 0;
    if (!S.next(0, cur)) return;
    f32x4 acc[2][2][4][2];
#pragma unroll
    for (int a = 0; a < 2; ++a)
#pragma unroll
        for (int b = 0; b < 2; ++b)
#pragma unroll
            for (int m = 0; m < 4; ++m)
#pragma unroll
                for (int n = 0; n < 2; ++n) acc[a][b][m][n] = (f32x4){0.f, 0.f, 0.f, 0.f};
    bf16x8 At[4][2], B0[2][2], B1[2][2];
    const char* cA = cur.pa; const char* cB = cur.pb;
    if constexpr (GATHER) { PG8_LOADROWS(voffG, cur); }
    PG8_STAGE(PG8_SB(0, 0), cB, voffB); PG8_STAGE(PG8_SB(0, 1), cB + hstep, voffB); PG8_STAGE_A(PG8_SA(0, 0), cA, 0); PG8_STAGE_A(PG8_SA(0, 1), cA, 1);
    if (wr == 1) PG8_BAR;
    PG8_WAIT_V(2); PG8_BAR;
    PG8_STAGE(PG8_SB(1, 0), cB + kstep, voffB); PG8_STAGE_A(PG8_SA(1, 0), cA + kstep, 0); PG8_STAGE(PG8_SB(1, 1), cB + hstep + kstep, voffB);
    PG8_WAIT_V(6); PG8_BAR;
    for (;;) {
        const bool has_next = S.next(ui + 1, nxt);
        const char* nA = has_next ? nxt.pa : cA; const char* nB = has_next ? nxt.pb : cB;
        if constexpr (GATHER) { if (has_next) { PG8_LOADROWS(voffGn, nxt); } }
        for (int t = 0; t < nt; t += 2) {
            const bool last = (t == nt - 2);
            const char* a1 = cA + (size_t)(t + 1) * kstep;
            const char* a2 = last ? nA : cA + (size_t)(t + 2) * kstep; const char* b2 = last ? nB : cB + (size_t)(t + 2) * kstep;
            const char* a3 = a2 + kstep; const char* b3 = b2 + kstep;
            PG8_LDB(B0, 0, 0); PG8_LDB(B1, 0, 1); PG8_SCHED; PG8_LDA(At, 0, 0); PG8_STAGE_A(PG8_SA(1, 1), a1, 1);
            if constexpr (GATHER) { if (last && has_next) {
#pragma unroll
                for (int _h = 0; _h < 2; ++_h)
#pragma unroll
                    for (int _i = 0; _i < 2; ++_i) voffG[_h][_i] = voffGn[_h][_i]; } }
            PG8_WAIT_V(8); PG8_WAIT_L(0); PG8_BAR; PG8_MMA(0, 0, At, B0); PG8_MMA(0, 1, At, B1); PG8_BAR; PG8_SCHED;
            PG8_LDA(At, 0, 1); PG8_STAGE(PG8_SB(0, 0), b2, voffB); PG8_STAGE(PG8_SB(0, 1), b2 + hstep, voffB); PG8_STAGE_A(PG8_SA(0, 0), a2, 0);
            PG8_WAIT_V(8); PG8_WAIT_L(0); PG8_BAR; PG8_MMA(1, 0, At, B0); PG8_MMA(1, 1, At, B1); PG8_BAR; PG8_SCHED;
            PG8_LDB(B0, 1, 0); PG8_LDB(B1, 1, 1); PG8_SCHED; PG8_LDA(At, 1, 0); PG8_STAGE_A(PG8_SA(0, 1), a2, 1);
            PG8_WAIT_V(8); PG8_WAIT_L(0); PG8_BAR; PG8_MMA(0, 0, At, B0); PG8_MMA(0, 1, At, B1); PG8_BAR; PG8_SCHED;
            PG8_LDA(At, 1, 1); PG8_STAGE(PG8_SB(1, 0), b3, voffB); PG8_STAGE(PG8_SB(1, 1), b3 + hstep, voffB); PG8_STAGE_A(PG8_SA(1, 0), a3, 0);
            PG8_WAIT_V(8); PG8_WAIT_L(0); PG8_BAR; PG8_MMA(1, 0, At, B0); PG8_MMA(1, 1, At, B1); PG8_BAR; PG8_SCHED;
        }
        if (wr == 0) PG8_BAR;
        E(acc, cur, wr, wc, fr, fq);
        if (!has_next) break;
#pragma unroll
        for (int a = 0; a < 2; ++a)
#pragma unroll
            for (int b = 0; b < 2; ++b)
#pragma unroll
                for (int m = 0; m < 4; ++m)
#pragma unroll
                    for (int n = 0; n < 2; ++n) acc[a][b][m][n] = (f32x4){0.f, 0.f, 0.f, 0.f};
        cur = nxt; cA = nA; cB = nB; ++ui;
        if (wr == 1) PG8_BAR;
    }
    PG8_WAIT_V(0);
    PG8_BAR;
#undef PG8_SA
#undef PG8_SB
#undef PG8_STAGE
#undef PG8_STAGE_A
#undef PG8_LDA
#undef PG8_LDB
#undef PG8_MMA
#undef PG8_WAIT_V
#undef PG8_WAIT_L
#undef PG8_BAR
#undef PG8_SCHED
#undef PG8_LOADROWS
}
}

#define XB_TMO      128
#define XB_XCNT(j)  (256  + 64 * (j))
#define XB_XSUB(j)  (1280 + 64 * (j))
#define XB_XGEN(j)  (2304 + 64 * (j))
#define XB_TOP      3328
#define XB_TOPGEN   3392
#define XCD_BAR_WORDS 3456
#define XB_SPIN_CAP (1u << 18)
__device__ __forceinline__ unsigned xb_ld(unsigned* p)              { return __hip_atomic_load(p, __ATOMIC_RELAXED, __HIP_MEMORY_SCOPE_AGENT); }
__device__ __forceinline__ unsigned xb_add(unsigned* p, unsigned v) { return __hip_atomic_fetch_add(p, v, __ATOMIC_RELAXED, __HIP_MEMORY_SCOPE_AGENT); }
__device__ __forceinline__ unsigned xb_xcc_id() { return (unsigned)__builtin_amdgcn_s_getreg((3 << 11) | 20) & 0xFu; }
#define XB_SPIN(cond, bar) do { unsigned _sp = 0; while (cond) { __builtin_amdgcn_s_sleep(1); \
    if ((++_sp & 255u) == 0u) { if (xb_ld(&(bar)[XB_TMO])) break; if (_sp > XB_SPIN_CAP) { atomicAdd(&(bar)[XB_TMO], 1u); break; } } } } while (0)
struct XcdBarrier { unsigned* bar; unsigned x; volatile LAS unsigned* st; };
__device__ __forceinline__ XcdBarrier xcd_barrier_post(unsigned* bar, volatile LAS unsigned* st) {
    XcdBarrier b; b.bar = bar; b.x = xb_xcc_id(); b.st = st;
    if (threadIdx.x == 0) (void)xb_add(&bar[XB_XCNT(b.x)], 1u);
    return b;
}
__device__ __forceinline__ void xcd_barrier_complete(unsigned* bar, unsigned x, unsigned& nloc, unsigned& nx) {
    const unsigned G = gridDim.x * gridDim.y * gridDim.z;
    unsigned sum, cnt, mine, sp = 0u;
    for (;;) {
        sum = 0u; cnt = 0u; mine = 0u;
#pragma unroll
        for (unsigned j = 0; j < 16; ++j) { const unsigned c = xb_ld(&bar[XB_XCNT(j)]); sum += c; cnt += (c > 0u) ? 1u : 0u; mine = (j == x) ? c : mine; }
        if (sum == G) break;
        __builtin_amdgcn_s_sleep(1);
        if ((++sp & 255u) == 0u) { if (xb_ld(&bar[XB_TMO])) break; if (sp > XB_SPIN_CAP) { atomicAdd(&bar[XB_TMO], 1u); break; } }
    }
    nloc = mine > 0u ? mine : 1u; nx = cnt > 0u ? cnt : 1u;
}
__device__ __forceinline__ void xcd_barrier(const XcdBarrier& b) {
    asm volatile("s_waitcnt vmcnt(0)" ::: "memory");
    __syncthreads();
    if (threadIdx.x == 0) {
        unsigned* bar = b.bar;
        __builtin_amdgcn_s_waitcnt(0);
        unsigned nloc = b.st[0], nx = b.st[1];
        if (nloc == 0u) { xcd_barrier_complete(bar, b.x, nloc, nx); b.st[0] = nloc; b.st[1] = nx; }
        const unsigned old = xb_add(&bar[XB_XSUB(b.x)], 1u);
        const unsigned gen = old / nloc;
        if (old + 1u == (gen + 1u) * nloc) {
            __builtin_amdgcn_fence(__ATOMIC_RELEASE, "agent");
            asm volatile("s_waitcnt vmcnt(0)" ::: "memory");
            const unsigned og = xb_add(&bar[XB_TOP], 1u);
            const unsigned tg = og / nx;
            if (og + 1u == (tg + 1u) * nx) xb_add(&bar[XB_TOPGEN], 1u);
            else XB_SPIN(xb_ld(&bar[XB_TOPGEN]) == tg, bar);
            __builtin_amdgcn_fence(__ATOMIC_ACQUIRE, "agent");
            xb_add(&bar[XB_XGEN(b.x)], 1u);
            asm volatile("s_waitcnt vmcnt(0)" ::: "memory");
        } else {
            XB_SPIN(xb_ld(&bar[XB_XGEN(b.x)]) == gen, bar);
            __builtin_amdgcn_fence(__ATOMIC_ACQUIRE, "agent");
            asm volatile("s_waitcnt vmcnt(0)" ::: "memory");
        }
    }
    __syncthreads();
}

struct Frame {
    LAS unsigned char* lds;
    volatile LAS unsigned* MISC;
    unsigned* ctl;
    int tid, lane, wave, G, bid;
    const float* in[28]; float* out; unsigned char* ws;
};
#define IN_X 0
#define IN_C 1
#define IN_WADA 2
#define IN_BADA 3
#define IN_GN1 4
#define IN_WIN 5
#define IN_WDW 6
#define IN_BDW 7
#define IN_GCLN 8
#define IN_BCLN 9
#define IN_WPW 10
#define IN_BPW 11
#define IN_WA2 12
#define IN_BA2 13
#define IN_GGLA 14
#define IN_WGO 15
#define IN_WOUT 16
#define IN_GN2 17
#define IN_WRG 18
#define IN_BRG 19
#define IN_WRE 20
#define IN_BRE 21
#define IN_W1 22
#define IN_W3 23
#define IN_W2 24
#define IN_WADAF 25
#define IN_BADAF 26
#define IN_GFIN 27

__device__ __forceinline__ void st_bf16x8(bf16_t* p, f32x4 v0, f32x4 v1) {
    u32x4 w; w.x = cvt_pk_bf16(v0[0], v0[1]); w.y = cvt_pk_bf16(v0[2], v0[3]); w.z = cvt_pk_bf16(v1[0], v1[1]); w.w = cvt_pk_bf16(v1[2], v1[3]);
    *(u32x4*)p = w;
}
__device__ __forceinline__ void ld_bf16x8(const bf16_t* p, f32x4& v0, f32x4& v1) {
    const u32x4 w = *(const u32x4*)p;
    v0 = (f32x4){bflo(w.x), bfhi(w.x), bflo(w.y), bfhi(w.y)}; v1 = (f32x4){bflo(w.z), bfhi(w.z), bflo(w.w), bfhi(w.w)};
}
__device__ __forceinline__ f32x4 sig4(f32x4 v) { return (f32x4){sigmoidf_(v[0]), sigmoidf_(v[1]), sigmoidf_(v[2]), sigmoidf_(v[3])}; }
__device__ __forceinline__ f32x4 silu4(f32x4 v) { return (f32x4){siluf_(v[0]), siluf_(v[1]), siluf_(v[2]), siluf_(v[3])}; }

struct EpiProj {
    static constexpr bool PERM = true;
    unsigned char* ws; unsigned char* outp;
    __device__ __forceinline__ void operator()(const f32x4 (&acc)[2][2][4][2], const pg8::Unit& u, int wr, int wc, int fr, int fq) const {
        const int row0 = u.pm * 256 + wr * 64 + fr, c8 = wc * 32 + 8 * fq, pn = u.pn;
        if (pn < 4) {
            bf16_t* Z = (bf16_t*)(ws + WS_Z);
#pragma unroll
            for (int ai = 0; ai < 2; ++ai)
#pragma unroll
                for (int m = 0; m < 4; ++m) { const int row = row0 + ai * 128 + m * 16;
                    const f32x4 z0 = acc[ai][0][m][0] * sig4(acc[ai][1][m][0]), z1 = acc[ai][0][m][1] * sig4(acc[ai][1][m][1]);
                    st_bf16x8(Z + (size_t)row * CONV_DIM + 128 * pn + c8, z0, z1); }
        } else {
            int ld, col0, act; size_t boff;
            if (pn < 8) { ld = QKD; col0 = ((pn - 4) & 1) * 256; boff = WS_Q + (size_t)((pn - 4) >> 1) * (WS_K - WS_Q); act = 0; }
            else if (pn < 16) { ld = VD; col0 = ((pn - 8) & 3) * 256; boff = WS_V + (size_t)((pn - 8) >> 2) * (WS_RS - WS_V); act = (pn >= 12) ? 1 : 0; }
            else { ld = 2 * DM; col0 = (pn - 16) * 256; boff = 0; act = 2; }
            bf16_t* base = (bf16_t*)(((pn >= 16) ? outp : ws) + boff);
#pragma unroll
            for (int ai = 0; ai < 2; ++ai)
#pragma unroll
                for (int m = 0; m < 4; ++m) { const int row = row0 + ai * 128 + m * 16;
#pragma unroll
                    for (int bj = 0; bj < 2; ++bj) { f32x4 v0 = acc[ai][bj][m][0], v1 = acc[ai][bj][m][1];
                        if (act == 1) { v0 = silu4(v0); v1 = silu4(v1); } else if (act == 2) { v0 = sig4(v0); v1 = sig4(v1); }
                        st_bf16x8(base + (size_t)row * ld + col0 + bj * 128 + c8, v0, v1); } }
        }
    }
};
struct EpiConvPw {
    static constexpr bool PERM = true;
    bf16_t* M1; const bf16_t* Gt; const float* bias;
    __device__ __forceinline__ void operator()(const f32x4 (&acc)[2][2][4][2], const pg8::Unit& u, int wr, int wc, int fr, int fq) const {
        const int row0 = u.pm * 256 + wr * 64 + fr, col0 = u.pn * 256 + wc * 32 + 8 * fq;
#pragma unroll
        for (int bj = 0; bj < 2; ++bj) { const int col = col0 + bj * 128;
            const f32x4 b0 = *(const f32x4*)(bias + col), b1 = *(const f32x4*)(bias + col + 4);
#pragma unroll
            for (int ai = 0; ai < 2; ++ai)
#pragma unroll
                for (int m = 0; m < 4; ++m) { const int row = row0 + ai * 128 + m * 16;
                    f32x4 g0, g1; ld_bf16x8(Gt + (size_t)row * (2 * DM) + col, g0, g1);
                    st_bf16x8(M1 + (size_t)row * DM + col, g0 * (acc[ai][bj][m][0] + b0), g1 * (acc[ai][bj][m][1] + b1)); } }
    }
};
struct EpiMerge {
    static constexpr bool PERM = true;
    bf16_t* M1; const bf16_t* Gt;
    __device__ __forceinline__ void operator()(const f32x4 (&acc)[2][2][4][2], const pg8::Unit& u, int wr, int wc, int fr, int fq) const {
        const int row0 = u.pm * 256 + wr * 64 + fr, col0 = u.pn * 256 + wc * 32 + 8 * fq;
#pragma unroll
        for (int ai = 0; ai < 2; ++ai)
#pragma unroll
            for (int m = 0; m < 4; ++m) { const int row = row0 + ai * 128 + m * 16;
#pragma unroll
                for (int bj = 0; bj < 2; ++bj) { const int col = col0 + bj * 128;
                    f32x4 g0, g1, p0, p1; ld_bf16x8(Gt + (size_t)row * (2 * DM) + DM + col, g0, g1); ld_bf16x8(M1 + (size_t)row * DM + col, p0, p1);
                    st_bf16x8(M1 + (size_t)row * DM + col, p0 + g0 * acc[ai][bj][m][0], p1 + g1 * acc[ai][bj][m][1]); } }
    }
};
struct EpiH {
    static constexpr bool PERM = false;
    const float* x; float* Hout; const float* mod;
    __device__ __forceinline__ void operator()(const f32x4 (&acc)[2][2][4][2], const pg8::Unit& u, int wr, int wc, int fr, int fq) const {
        const int row0 = u.pm * 256 + wr * 64 + fr, col0 = u.pn * 256 + wc * 32 + 4 * fq;
        const int b = (u.pm * 256) / SEQ;
        f32x4 ga[2][2];
#pragma unroll
        for (int bj = 0; bj < 2; ++bj)
#pragma unroll
            for (int n = 0; n < 2; ++n) ga[bj][n] = *(const f32x4*)(mod + (size_t)b * (NMOD * DM) + 2 * DM + col0 + bj * 128 + n * 16);
#pragma unroll
        for (int ai = 0; ai < 2; ++ai)
#pragma unroll
            for (int m = 0; m < 4; ++m) { const size_t off = (size_t)(row0 + ai * 128 + m * 16) * DM + col0;
#pragma unroll
                for (int bj = 0; bj < 2; ++bj)
#pragma unroll
                    for (int n = 0; n < 2; ++n) { const f32x4 xv = *(const f32x4*)(x + off + bj * 128 + n * 16);
                        *(f32x4*)(Hout + off + bj * 128 + n * 16) = xv + ga[bj][n] * acc[ai][bj][m][n]; } }
    }
};
struct EpiUp {
    static constexpr bool PERM = true;
    bf16_t* HID;
    __device__ __forceinline__ void operator()(const f32x4 (&acc)[2][2][4][2], const pg8::Unit& u, int wr, int wc, int fr, int fq) const {
        const int row0 = u.pm * 256 + wr * 64 + fr, col = u.pn * 128 + wc * 32 + 8 * fq;
#pragma unroll
        for (int ai = 0; ai < 2; ++ai)
#pragma unroll
            for (int m = 0; m < 4; ++m) { const int row = row0 + ai * 128 + m * 16;
                st_bf16x8(HID + (size_t)row * DE + col, silu4(acc[ai][0][m][0]) * acc[ai][1][m][0], silu4(acc[ai][0][m][1]) * acc[ai][1][m][1]); }
    }
};
struct EpiDown {
    static constexpr bool PERM = true;
    bf16_t* Y;
    __device__ __forceinline__ void operator()(const f32x4 (&acc)[2][2][4][2], const pg8::Unit& u, int wr, int wc, int fr, int fq) const {
        const int row0 = u.pm * 256 + wr * 64 + fr, col0 = u.pn * 256 + wc * 32 + 8 * fq;
#pragma unroll
        for (int ai = 0; ai < 2; ++ai)
#pragma unroll
            for (int m = 0; m < 4; ++m) { const int row = row0 + ai * 128 + m * 16;
#pragma unroll
                for (int bj = 0; bj < 2; ++bj) st_bf16x8(Y + (size_t)row * DM + col0 + bj * 128, acc[ai][bj][m][0], acc[ai][bj][m][1]); }
    }
};

struct MoeOrder {
    const LAS int* tstart; const LAS int* cnt; int G, c, NT;
    const char* A; const char* W; const int* lists; size_t wstride, astride_tile, wtile;
    bool gather;
    __device__ __forceinline__ bool next(int i, pg8::Unit& u) const {
        const int L = i * G + c; const int ntile = tstart[NE];
        if (L >= ntile * NT) return false;
        const int mt = L / NT, pn = L % NT;
        int e = 0;
#pragma unroll 1
        while (e < NE - 1 && tstart[e + 1] <= mt) ++e;
        const int lt = mt - tstart[e];
        u.pm = mt; u.pn = pn;
        u.pb = W + (size_t)e * wstride + (size_t)pn * wtile;
        if (gather) { u.pa = A; u.rows = lists + (size_t)e * T + lt * 256; const int rem = cnt[e] - lt * 256; u.nvalid = rem < 256 ? rem : 256; }
        else { u.pa = A + (size_t)mt * astride_tile; u.rows = nullptr; u.nvalid = 256; }
        return true;
    }
};

__device__ __forceinline__ void tr_item(const float* W, int ldw, int k0, int n0, bf16_t* D, int K, int drow0, float scale, LAS float* scr, int lane) {
#pragma unroll 8
    for (int i = 0; i < 32; ++i) { const int kk = 2 * i + (lane >> 5); scr[kk * 33 + (lane & 31)] = W[(size_t)(k0 + kk) * ldw + n0 + (lane & 31)]; }
    LDS_WAIT(); asm volatile("" ::: "memory");
    const int c = lane & 7;
#pragma unroll
    for (int j = 0; j < 4; ++j) { const int n = (lane >> 3) + 8 * j; const LAS float* s = scr + (8 * c) * 33 + n;
        u32x4 o; o.x = cvt_pk_bf16(s[0 * 33] * scale, s[1 * 33] * scale); o.y = cvt_pk_bf16(s[2 * 33] * scale, s[3 * 33] * scale);
        o.z = cvt_pk_bf16(s[4 * 33] * scale, s[5 * 33] * scale); o.w = cvt_pk_bf16(s[6 * 33] * scale, s[7 * 33] * scale);
        *(u32x4*)(D + (size_t)(drow0 + n) * K + k0 + 8 * c) = o; }
    LDS_WAIT(); asm volatile("" ::: "memory");
}
__device__ __forceinline__ void p0_prologue(Frame& F) {
    {
        LAS float* cact = (LAS float*)F.lds;
        LAS float* red = (LAS float*)(F.lds + 32768);
        const float* c = F.in[IN_C];
        for (int i = F.tid; i < BATCH * DM; i += NTHR) cact[i] = siluf_(c[i]);
        __syncthreads();
        float* mod = (float*)(F.ws + WS_MOD); float* modf = mod + BATCH * NMOD * DM;
        for (int cb = F.bid; cb < 256; cb += F.G) {
            const int j0 = cb * 32, col = F.tid & 31, kq = F.tid >> 5;
            const bool isf = j0 >= NMOD * DM;
            const float* W = isf ? F.in[IN_WADAF] : F.in[IN_WADA]; const int ldw = isf ? 2 * DM : NMOD * DM; const int jj = isf ? j0 - NMOD * DM : j0;
            float a[8];
#pragma unroll
            for (int b = 0; b < 8; ++b) a[b] = 0.f;
            for (int k = kq * 64; k < kq * 64 + 64; ++k) { const float w = W[(size_t)k * ldw + jj + col];
#pragma unroll
                for (int b = 0; b < 8; ++b) a[b] += cact[b * DM + k] * w; }
#pragma unroll
            for (int b = 0; b < 8; ++b) red[(kq * 8 + b) * 32 + col] = a[b];
            __syncthreads();
            if (F.tid < 256) { const int b = F.tid >> 5; float s = 0.f;
#pragma unroll
                for (int q = 0; q < 16; ++q) s += red[(q * 8 + b) * 32 + col];
                if (isf) modf[b * 2 * DM + jj + col] = s + F.in[IN_BADAF][jj + col]; else mod[b * NMOD * DM + jj + col] = s + F.in[IN_BADA][jj + col]; }
            __syncthreads();
        }
    }
    {
        float* wrt = (float*)(F.ws + WS_WRT); float* wa1t = (float*)(F.ws + WS_WA1T);
        for (int it = F.bid; it < NGRP + NE + LOWRANK; it += F.G)
            for (int k = F.tid; k < DM; k += NTHR) {
                if (it < NGRP) wrt[it * DM + k] = F.in[IN_WRG][k * NGRP + it];
                else if (it < NGRP + NE) wrt[it * DM + k] = F.in[IN_WRE][k * NE + (it - NGRP)];
                else wa1t[(it - NGRP - NE) * DM + k] = F.in[IN_WIN][(size_t)k * IN_DIM + 4096 + (it - NGRP - NE)];
            }
    }
    LAS float* scr = (LAS float*)(F.lds + F.wave * 16384);
    const int gw = F.bid * NWAVES + F.wave, NGW = F.G * NWAVES;
    constexpr int I_IN = (NPROJ / 32) * (DM / 64), I_PW = (DM / 32) * (CONV_DIM / 64), I_GO = (DM / 32) * (VD / 64), I_OUT = (DM / 32) * (DM / 64);
    constexpr int I_13E = (2 * DE / 32) * (DM / 64), I_2E = (DM / 32) * (DE / 64);
    constexpr int NITEMS = I_IN + I_PW + I_GO + I_OUT + NE * I_13E + NE * I_2E;
    for (int it = gw; it < NITEMS; it += NGW) {
        int r = it;
        if (r < I_IN) { const int nb = r / 16, kb = r % 16, d0 = nb * 32; int src; float sc = 1.f;
            if (d0 < 1024) { const int j = d0 >> 8, w = d0 & 255; src = (w < 128) ? (128 * j + w) : (512 + 128 * j + (w - 128)); }
            else if (d0 < 4096) { src = d0; if (d0 < 1536) sc = 0.08838834764831845f; }
            else src = d0 + 16;
            tr_item(F.in[IN_WIN], IN_DIM, kb * 64, src, (bf16_t*)(F.ws + WS_WIN), DM, d0, sc, scr, F.lane); continue; }
        r -= I_IN;
        if (r < I_PW) { const int nb = r / 8, kb = r % 8; tr_item(F.in[IN_WPW], DM, kb * 64, nb * 32, (bf16_t*)(F.ws + WS_WPW), CONV_DIM, nb * 32, 1.f, scr, F.lane); continue; }
        r -= I_PW;
        if (r < I_GO) { const int nb = r / 16, kb = r % 16; tr_item(F.in[IN_WGO], DM, kb * 64, nb * 32, (bf16_t*)(F.ws + WS_WGO), VD, nb * 32, 1.f, scr, F.lane); continue; }
        r -= I_GO;
        if (r < I_OUT) { const int nb = r / 16, kb = r % 16; tr_item(F.in[IN_WOUT], DM, kb * 64, nb * 32, (bf16_t*)(F.ws + WS_WOUT), DM, nb * 32, 1.f, scr, F.lane); continue; }
        r -= I_OUT;
        if (r < NE * I_13E) { const int e = r / I_13E, q = r % I_13E, nb = q / 16, kb = q % 16, d0 = nb * 32, p = d0 >> 8, w = d0 & 255;
            const float* src = (w < 128) ? F.in[IN_W1] : F.in[IN_W3]; const int scol = 128 * p + (w & 127);
            tr_item(src + (size_t)e * DM * DE, DE, kb * 64, scol, (bf16_t*)(F.ws + WS_W13) + (size_t)e * (2 * DE) * DM, DM, d0, 1.f, scr, F.lane); continue; }
        r -= NE * I_13E;
        { const int e = r / I_2E, q = r % I_2E, nb = q / 8, kb = q % 8;
            tr_item(F.in[IN_W2] + (size_t)e * DE * DM, DM, kb * 64, nb * 32, (bf16_t*)(F.ws + WS_W2) + (size_t)e * DM * DE, DE, nb * 32, 1.f, scr, F.lane); }
    }
}

__device__ __forceinline__ void p1a_norm(Frame& F) {
    LAS float* wa1 = (LAS float*)F.lds;
    LAS float* wa2 = (LAS float*)(F.lds + 65536);
    { const u32x4* s1 = (const u32x4*)(F.ws + WS_WA1T); const u32x4* s2 = (const u32x4*)F.in[IN_WA2];
      for (int i = F.tid; i < LOWRANK * DM / 4; i += NTHR) ((LAS u32x4*)wa1)[i] = s1[i];
      for (int i = F.tid; i < LOWRANK * QKD / 4; i += NTHR) ((LAS u32x4*)wa2)[i] = s2[i]; }
    __syncthreads();
    const float* mod = (const float*)(F.ws + WS_MOD);
    bf16_t* U = (bf16_t*)(F.ws + WS_U); float* LG = (float*)(F.ws + WS_LG);
    const int gw = F.bid * NWAVES + F.wave, NGW = F.G * NWAVES, lane = F.lane;
    f32x4 vn[2][4];
    if (gw < T / 2) {
#pragma unroll
        for (int q = 0; q < 2; ++q) { const f32x4* xr = (const f32x4*)(F.in[IN_X] + (size_t)(gw * 2 + q) * DM) + lane;
#pragma unroll
            for (int j = 0; j < 4; ++j) vn[q][j] = xr[64 * j]; } }
    for (int rp = gw; rp < T / 2; rp += NGW) {
        const int row0 = rp * 2, b = row0 / SEQ;
        f32x4 v[2][4]; float ss[2];
#pragma unroll
        for (int q = 0; q < 2; ++q)
#pragma unroll
            for (int j = 0; j < 4; ++j) v[q][j] = vn[q][j];
        if (rp + NGW < T / 2) {
#pragma unroll
            for (int q = 0; q < 2; ++q) { const f32x4* xr = (const f32x4*)(F.in[IN_X] + (size_t)((rp + NGW) * 2 + q) * DM) + lane;
#pragma unroll
                for (int j = 0; j < 4; ++j) vn[q][j] = xr[64 * j]; } }
#pragma unroll
        for (int q = 0; q < 2; ++q) { float a = 0.f;
#pragma unroll
            for (int j = 0; j < 4; ++j) a += (v[q][j][0] * v[q][j][0] + v[q][j][1] * v[q][j][1]) + (v[q][j][2] * v[q][j][2] + v[q][j][3] * v[q][j][3]);
            ss[q] = a; }
        const float rinv0 = rsqf_(wave_sum(ss[0]) * (1.0f / DM) + EPS), rinv1 = rsqf_(wave_sum(ss[1]) * (1.0f / DM) + EPS);
        const float* sh = mod + (size_t)b * NMOD * DM; const float* sc = sh + DM;
#pragma unroll
        for (int j = 0; j < 4; ++j) { const int k = 4 * lane + 256 * j;
            const f32x4 g = *(const f32x4*)(F.in[IN_GN1] + k), s1 = *(const f32x4*)(sc + k) + 1.0f, s0 = *(const f32x4*)(sh + k);
            v[0][j] = (v[0][j] * rinv0 * g) * s1 + s0; v[1][j] = (v[1][j] * rinv1 * g) * s1 + s0; }
#pragma unroll
        for (int q = 0; q < 2; ++q) { u32x2* o8 = (u32x2*)(U + (size_t)(row0 + q) * DM) + lane;
#pragma unroll
            for (int j = 0; j < 4; ++j) { u32x2 w; w.x = cvt_pk_bf16(v[q][j][0], v[q][j][1]); w.y = cvt_pk_bf16(v[q][j][2], v[q][j][3]); o8[64 * j] = w; } }
        float a1[2][LOWRANK];
#pragma unroll
        for (int i = 0; i < LOWRANK; ++i) { float s0 = 0.f, s1 = 0.f;
#pragma unroll
            for (int j = 0; j < 4; ++j) { const f32x4 w = *(const LAS f32x4*)(wa1 + i * DM + 4 * lane + 256 * j);
                s0 += (v[0][j][0] * w[0] + v[0][j][1] * w[1]) + (v[0][j][2] * w[2] + v[0][j][3] * w[3]); s1 += (v[1][j][0] * w[0] + v[1][j][1] * w[1]) + (v[1][j][2] * w[2] + v[1][j][3] * w[3]); }
            a1[0][i] = wave_sum(s0); a1[1][i] = wave_sum(s1); }
        const f32x4 bb0 = *(const f32x4*)(F.in[IN_BA2] + 8 * lane), bb1 = *(const f32x4*)(F.in[IN_BA2] + 8 * lane + 4);
        f32x4 y[2][2] = {{bb0, bb1}, {bb0, bb1}};
#pragma unroll
        for (int i = 0; i < LOWRANK; ++i) { const f32x4 w0 = *(const LAS f32x4*)(wa2 + i * QKD + 8 * lane), w1 = *(const LAS f32x4*)(wa2 + i * QKD + 8 * lane + 4);
            y[0][0] += w0 * a1[0][i]; y[0][1] += w1 * a1[0][i]; y[1][0] += w0 * a1[1][i]; y[1][1] += w1 * a1[1][i]; }
#pragma unroll
        for (int q = 0; q < 2; ++q) { f32x4 l0, l1;
#pragma unroll
            for (int t = 0; t < 4; ++t) { const float a = y[q][0][t], c = y[q][1][t];
                l0[t] = (fminf(a, 0.f) - __logf(1.0f + __expf(-fabsf(a)))) * (1.0f / 16.0f); l1[t] = (fminf(c, 0.f) - __logf(1.0f + __expf(-fabsf(c)))) * (1.0f / 16.0f); }
            f32x4* lo = (f32x4*)(LG + (size_t)(row0 + q) * QKD + 8 * lane); lo[0] = l0; lo[1] = l1; }
    }
}

__device__ __forceinline__ void p2_scan_naive(Frame& F) {
    LAS float* qs = (LAS float*)F.lds;
    LAS float* ks = qs + 32 * 128;
    LAS float* es = ks + 32 * 128;
    LAS float* vs = es + 32 * 128;
    LAS float* po = vs + 32 * 32;
    const bf16_t* Q = (const bf16_t*)(F.ws + WS_Q); const bf16_t* Kb = (const bf16_t*)(F.ws + WS_K); bf16_t* V = (bf16_t*)(F.ws + WS_V); const float* LG = (const float*)(F.ws + WS_LG);
    const int e = F.tid & 31, dg = F.tid >> 5;
    for (int item = F.bid; item < BATCH * NH * 8; item += F.G) {
        const int sl = item & 7, h = (item >> 3) & 3, b = item >> 5;
        float S[8];
#pragma unroll
        for (int i = 0; i < 8; ++i) S[i] = 0.f;
        for (int t0 = 0; t0 < SEQ; t0 += 32) {
            const size_t rowb = (size_t)b * SEQ + t0;
            for (int i = F.tid; i < 32 * 128; i += NTHR) { const int t = i >> 7, d = i & 127;
                qs[i] = bf2f(Q[(rowb + t) * QKD + h * DK + d]); ks[i] = bf2f(Kb[(rowb + t) * QKD + h * DK + d]); es[i] = __expf(LG[(rowb + t) * QKD + h * DK + d]); }
            for (int i = F.tid; i < 32 * 32; i += NTHR) { const int t = i >> 5, ee = i & 31; vs[i] = bf2f(V[(rowb + t) * VD + h * DV + sl * 32 + ee]); }
            __syncthreads();
            for (int t = 0; t < 32; ++t) { const float vv = vs[t * 32 + e]; float p = 0.f;
#pragma unroll
                for (int i = 0; i < 8; ++i) { const int d = dg * 8 + i; S[i] = es[t * 128 + d] * S[i] + ks[t * 128 + d] * vv; p += qs[t * 128 + d] * S[i]; }
                po[(t * 16 + dg) * 32 + e] = p; }
            __syncthreads();
            for (int i = F.tid; i < 32 * 32; i += NTHR) { const int t = i >> 5, ee = i & 31; float s = 0.f;
#pragma unroll
                for (int q = 0; q < 16; ++q) s += po[(t * 16 + q) * 32 + ee];
                V[(rowb + t) * VD + h * DV + sl * 32 + ee] = (bf16_t)(cvt_pk_bf16(s, 0.f) & 0xffffu); }
            __syncthreads();
        }
    }
}

#define BAR_LDS() do { asm volatile("s_waitcnt lgkmcnt(0)" ::: "memory"); __builtin_amdgcn_s_barrier(); asm volatile("" ::: "memory"); } while (0)
namespace scan {
constexpr int QS = 272, KS = 144;
constexpr int OFF_QE = 0, OFF_KI = OFF_QE + 64 * QS, OFF_KD = OFF_KI + 64 * QS, OFF_VT = OFF_KD + 128 * KS, OFF_AT = OFF_VT + 32 * KS;
constexpr int OFF_SB = OFF_AT + 64 * KS, SB_BYTES = 32 * QS, OFF_EBL = OFF_SB + 2 * SB_BYTES, OFF_PART = OFF_EBL + 512, OFF_END = OFF_PART + 8 * 128 * 4;
static_assert(OFF_END <= MISC_OFF, "scan LDS");
struct Ctx { LAS unsigned char* L; const float* gp; const bf16_t* qp; const bf16_t* kp; bf16_t* vp; bf16_t* op; int tid, lane, wave, c, g, cp, mi, ne; };
__device__ __forceinline__ void chunk(const Ctx& X, const int ch, f32x2 (&gq)[8], unsigned (&qq)[8], unsigned (&kk)[8], u32x2& vv, f32x4 (&Sacc)[2]) {
    LAS unsigned char* L = X.L; const int wave = X.wave, cp = X.cp, c = X.c, g = X.g, mi = X.mi, ne = X.ne, tid = X.tid;
    const int cur = ch & 1, nxt = cur ^ 1;
    float b0[8], b1[8]; { float a0 = 0.f, a1 = 0.f;
#pragma unroll
        for (int r = 0; r < 8; ++r) { a0 += gq[r][0]; b0[r] = a0; a1 += gq[r][1]; b1[r] = a1; }
        *(LAS f32x2*)(L + OFF_PART + (wave * 128 + 2 * cp) * 4) = (f32x2){a0, a1}; }
    BAR_LDS();
    { float off0 = 0.f, off1 = 0.f, tot0 = 0.f, tot1 = 0.f;
#pragma unroll
        for (int w = 0; w < 8; ++w) { const f32x2 p = *(const LAS f32x2*)(L + OFF_PART + (w * 128 + 2 * cp) * 4); if (w < wave) { off0 += p[0]; off1 += p[1]; } tot0 += p[0]; tot1 += p[1]; }
        const float el0 = __expf(tot0), el1 = __expf(tot1);
        if (wave == 0) *(LAS f32x2*)(L + OFF_EBL + 8 * cp) = (f32x2){el0, el1};
        unsigned kd0[4], kd1[4]; float pk0 = 0.f, pk1 = 0.f;
#pragma unroll
        for (int r = 0; r < 8; ++r) { const int i = 8 * wave + r;
            const float e0 = __expf(b0[r] + off0), e1 = __expf(b1[r] + off1); const float i0 = __builtin_amdgcn_rcpf(e0), i1 = __builtin_amdgcn_rcpf(e1);
            const float q0 = bflo(qq[r]), q1 = bfhi(qq[r]), k0 = bflo(kk[r]) * i0, k1 = bfhi(kk[r]) * i1;
            *(LAS unsigned*)(L + OFF_QE + i * QS + 4 * cp) = cvt_pk_bf16_c(q0 * e0, q1 * e1);
            *(LAS unsigned*)(L + OFF_KI + i * QS + 4 * cp) = cvt_pk_bf16_c(k0, k1);
            const float d0 = k0 * el0, d1 = k1 * el1;
            if (r & 1) { kd0[r >> 1] = cvt_pk_bf16_c(pk0, d0); kd1[r >> 1] = cvt_pk_bf16_c(pk1, d1); } else { pk0 = d0; pk1 = d1; } }
        *(LAS u32x4*)(L + OFF_KD + (2 * cp) * KS + 16 * wave) = (u32x4){kd0[0], kd0[1], kd0[2], kd0[3]};
        *(LAS u32x4*)(L + OFF_KD + (2 * cp + 1) * KS + 16 * wave) = (u32x4){kd1[0], kd1[1], kd1[2], kd1[3]};
        const int j = tid >> 3, e4 = (tid & 7) * 4;
        *(LAS unsigned short*)(L + OFF_VT + (e4 + 0) * KS + 2 * j) = (unsigned short)(vv.x & 0xffffu);
        *(LAS unsigned short*)(L + OFF_VT + (e4 + 1) * KS + 2 * j) = (unsigned short)(vv.x >> 16);
        *(LAS unsigned short*)(L + OFF_VT + (e4 + 2) * KS + 2 * j) = (unsigned short)(vv.y & 0xffffu);
        *(LAS unsigned short*)(L + OFF_VT + (e4 + 3) * KS + 2 * j) = (unsigned short)(vv.y >> 16);
    }
    if (ch + 2 < SEQ / 64) { const size_t adv = (size_t)(ch + 2) * 64;
#pragma unroll
        for (int r = 0; r < 8; ++r) { gq[r] = *(const f32x2*)(X.gp + (adv + r) * QKD); qq[r] = *(const unsigned*)(X.qp + (adv + r) * QKD); kk[r] = *(const unsigned*)(X.kp + (adv + r) * QKD); }
        vv = *(const u32x2*)(X.vp + adv * VD); }
    BAR_LDS();
#pragma unroll 1
    for (int tix = wave; tix < 10; tix += 8) {
        const int tm = (tix >= 6) ? 3 : (tix >= 3) ? 2 : (tix >= 1) ? 1 : 0; const int tn = tix - ((tm * (tm + 1)) >> 1);
        f32x4 a = (f32x4){0.f, 0.f, 0.f, 0.f};
#pragma unroll
        for (int ks = 0; ks < 4; ++ks) { const bf16x8 Af = *(const LAS bf16x8*)(L + OFF_KI + (16 * tn + c) * QS + (32 * ks + 8 * g) * 2), Bf = *(const LAS bf16x8*)(L + OFF_QE + (16 * tm + c) * QS + (32 * ks + 8 * g) * 2);
            a = __builtin_amdgcn_mfma_f32_16x16x32_bf16(Af, Bf, a, 0, 0, 0); }
        if (tm == tn) {
#pragma unroll
            for (int r = 0; r < 4; ++r) if (4 * g + r > c) a[r] = 0.f; }
        *(LAS u32x2*)(L + OFF_AT + (16 * tm + c) * KS + (16 * tn + 4 * g) * 2) = (u32x2){cvt_pk_bf16_c(a[0], a[1]), cvt_pk_bf16_c(a[2], a[3])};
    }
    f32x4 oacc = (f32x4){0.f, 0.f, 0.f, 0.f};
#pragma unroll
    for (int ks = 0; ks < 4; ++ks) { const bf16x8 Af = *(const LAS bf16x8*)(L + OFF_SB + cur * SB_BYTES + (16 * ne + c) * QS + (32 * ks + 8 * g) * 2), Bf = *(const LAS bf16x8*)(L + OFF_QE + (16 * mi + c) * QS + (32 * ks + 8 * g) * 2);
        oacc = __builtin_amdgcn_mfma_f32_16x16x32_bf16(Af, Bf, oacc, 0, 0, 0); }
    BAR_LDS();
    { const bf16x8 Af = *(const LAS bf16x8*)(L + OFF_VT + (16 * ne + c) * KS + (8 * g) * 2), Bf = *(const LAS bf16x8*)(L + OFF_AT + (16 * mi + c) * KS + (8 * g) * 2);
        oacc = __builtin_amdgcn_mfma_f32_16x16x32_bf16(Af, Bf, oacc, 0, 0, 0); }
    if (mi >= 2) { const bf16x8 Af = *(const LAS bf16x8*)(L + OFF_VT + (16 * ne + c) * KS + (32 + 8 * g) * 2), Bf = *(const LAS bf16x8*)(L + OFF_AT + (16 * mi + c) * KS + (32 + 8 * g) * 2);
        oacc = __builtin_amdgcn_mfma_f32_16x16x32_bf16(Af, Bf, oacc, 0, 0, 0); }
    *(u32x2*)(X.op + ((size_t)ch * 64 + 16 * mi + c) * VD) = (u32x2){cvt_pk_bf16_c(oacc[0], oacc[1]), cvt_pk_bf16_c(oacc[2], oacc[3])};
#pragma unroll
    for (int tt = 0; tt < 2; ++tt) { const int md = 2 * mi + tt;
        const f32x4 el = *(const LAS f32x4*)(L + OFF_EBL + (16 * md + 4 * g) * 4);
        f32x4 sa = Sacc[tt] * el;
#pragma unroll
        for (int ks = 0; ks < 2; ++ks) { const bf16x8 Af = *(const LAS bf16x8*)(L + OFF_KD + (16 * md + c) * KS + (32 * ks + 8 * g) * 2), Bf = *(const LAS bf16x8*)(L + OFF_VT + (16 * ne + c) * KS + (32 * ks + 8 * g) * 2);
            sa = __builtin_amdgcn_mfma_f32_16x16x32_bf16(Af, Bf, sa, 0, 0, 0); }
        Sacc[tt] = sa;
        *(LAS u32x2*)(L + OFF_SB + nxt * SB_BYTES + (16 * ne + c) * QS + (16 * md + 4 * g) * 2) = (u32x2){cvt_pk_bf16_c(sa[0], sa[1]), cvt_pk_bf16_c(sa[2], sa[3])}; }
    BAR_LDS();
}
}
__device__ __forceinline__ void p2_scan(Frame& F) {
    using namespace scan;
    const bf16_t* Q = (const bf16_t*)(F.ws + WS_Q); const bf16_t* Kb = (const bf16_t*)(F.ws + WS_K); bf16_t* V = (bf16_t*)(F.ws + WS_V); const float* LG = (const float*)(F.ws + WS_LG);
    Ctx X; X.L = F.lds; X.tid = F.tid; X.lane = F.lane; X.wave = F.wave; X.c = F.lane & 15; X.g = F.lane >> 4; X.cp = F.tid & 63; X.mi = F.wave >> 1; X.ne = F.wave & 1;
    for (int item = F.bid; item < BATCH * NH * 8; item += F.G) {
        const int sl = item & 7, h = (item >> 3) & 3, b = item >> 5;
        for (int i = F.tid; i < (64 * KS + SB_BYTES) / 4; i += NTHR) ((LAS unsigned*)(X.L + OFF_AT))[i] = 0u;
        f32x4 Sacc[2]; Sacc[0] = (f32x4){0.f, 0.f, 0.f, 0.f}; Sacc[1] = (f32x4){0.f, 0.f, 0.f, 0.f};
        const size_t row00 = (size_t)b * SEQ;
        X.gp = LG + (row00 + 8 * F.wave) * QKD + h * DK + 2 * X.cp;
        X.qp = Q + (row00 + 8 * F.wave) * QKD + h * DK + 2 * X.cp;
        X.kp = Kb + (row00 + 8 * F.wave) * QKD + h * DK + 2 * X.cp;
        X.vp = V + (row00 + (F.tid >> 3)) * VD + h * DV + sl * 32 + (F.tid & 7) * 4;
        X.op = V + row00 * VD + h * DV + sl * 32 + 16 * X.ne + 4 * X.g;
        f32x2 gqA[8], gqB[8]; unsigned qqA[8], kkA[8], qqB[8], kkB[8]; u32x2 vvA, vvB;
#pragma unroll
        for (int r = 0; r < 8; ++r) { gqA[r] = *(const f32x2*)(X.gp + (size_t)r * QKD); qqA[r] = *(const unsigned*)(X.qp + (size_t)r * QKD); kkA[r] = *(const unsigned*)(X.kp + (size_t)r * QKD); }
        vvA = *(const u32x2*)X.vp;
#pragma unroll
        for (int r = 0; r < 8; ++r) { gqB[r] = *(const f32x2*)(X.gp + (size_t)(64 + r) * QKD); qqB[r] = *(const unsigned*)(X.qp + (size_t)(64 + r) * QKD); kkB[r] = *(const unsigned*)(X.kp + (size_t)(64 + r) * QKD); }
        vvB = *(const u32x2*)(X.vp + (size_t)64 * VD);
        BAR_LDS();
#pragma unroll 1
        for (int ch = 0; ch < SEQ / 64; ch += 2) {
            chunk(X, ch, gqA, qqA, kkA, vvA, Sacc);
            chunk(X, ch + 1, gqB, qqB, kkB, vvB, Sacc);
        }
    }
}

__device__ __forceinline__ void p2_conv(Frame& F) {
    constexpr int TT = 32, HALO = CONV_W - 1, ROWS = TT + HALO;
    LAS bf16_t* zt = (LAS bf16_t*)F.lds;
    LAS float* wd = (LAS float*)(F.lds + 65536);
    for (int i = F.tid; i < CONV_W * CONV_DIM; i += NTHR) wd[i] = F.in[IN_WDW][i];
    const bf16_t* Z = (const bf16_t*)(F.ws + WS_Z); bf16_t* Z2 = (bf16_t*)(F.ws + WS_Z2);
    const int lane = F.lane, ch = 8 * lane;
    f32x4 bd0 = *(const f32x4*)(F.in[IN_BDW] + ch), bd1 = *(const f32x4*)(F.in[IN_BDW] + ch + 4);
    f32x4 lg0 = *(const f32x4*)(F.in[IN_GCLN] + ch), lg1 = *(const f32x4*)(F.in[IN_GCLN] + ch + 4);
    f32x4 lb0 = *(const f32x4*)(F.in[IN_BCLN] + ch), lb1 = *(const f32x4*)(F.in[IN_BCLN] + ch + 4);
    for (int tile = F.bid; tile < T / TT; tile += F.G) {
        const int t0 = tile * TT, s0 = t0 % SEQ;
        __syncthreads();
        for (int i = F.tid; i < ROWS * 64; i += NTHR) { const int r = i >> 6, c8 = i & 63; const int s = s0 - HALO + r;
            u32x4 w = (u32x4){0u, 0u, 0u, 0u};
            if (s >= 0) w = *(const u32x4*)(Z + (size_t)(t0 - HALO + r) * CONV_DIM + c8 * 8);
            *(LAS u32x4*)(zt + r * CONV_DIM + c8 * 8) = w; }
        __syncthreads();
        for (int i = 0; i < TT / NWAVES; ++i) { const int tt = F.wave * (TT / NWAVES) + i;
            f32x4 a0 = bd0, a1 = bd1;
#pragma unroll
            for (int j = 0; j < CONV_W; ++j) { const u32x4 zw = *(const LAS u32x4*)(zt + (tt + j) * CONV_DIM + ch);
                const f32x4 w0 = *(const LAS f32x4*)(wd + j * CONV_DIM + ch), w1 = *(const LAS f32x4*)(wd + j * CONV_DIM + ch + 4);
                a0 += (f32x4){bflo(zw.x), bfhi(zw.x), bflo(zw.y), bfhi(zw.y)} * w0; a1 += (f32x4){bflo(zw.z), bfhi(zw.z), bflo(zw.w), bfhi(zw.w)} * w1; }
            float s = (a0[0] + a0[1]) + (a0[2] + a0[3]) + (a1[0] + a1[1]) + (a1[2] + a1[3]);
            const float mean = wave_sum(s) * (1.0f / CONV_DIM);
            a0 -= mean; a1 -= mean;
            float q = (a0[0] * a0[0] + a0[1] * a0[1]) + (a0[2] * a0[2] + a0[3] * a0[3]) + (a1[0] * a1[0] + a1[1] * a1[1]) + (a1[2] * a1[2] + a1[3] * a1[3]);
            const float rstd = rsqf_(wave_sum(q) * (1.0f / CONV_DIM) + EPS);
            a0 = a0 * rstd * lg0 + lb0; a1 = a1 * rstd * lg1 + lb1;
            st_bf16x8(Z2 + (size_t)(t0 + tt) * CONV_DIM + ch, silu4(a0), silu4(a1)); }
    }
    __syncthreads();
}

__device__ __forceinline__ void p2c_gate(Frame& F) {
    const bf16_t* O = (const bf16_t*)(F.ws + WS_V); bf16_t* RS = (bf16_t*)(F.ws + WS_RS);
    const int gw = F.bid * NWAVES + F.wave, NGW = F.G * NWAVES, lane = F.lane;
    f32x4 g[4];
#pragma unroll
    for (int j = 0; j < 4; ++j) g[j] = *(const f32x4*)(F.in[IN_GGLA] + 16 * lane + 4 * j);
    for (int row = gw; row < T; row += NGW) {
        f32x4 o[4], r[4];
        ld_bf16x8(O + (size_t)row * VD + 16 * lane, o[0], o[1]); ld_bf16x8(O + (size_t)row * VD + 16 * lane + 8, o[2], o[3]);
        ld_bf16x8(RS + (size_t)row * VD + 16 * lane, r[0], r[1]); ld_bf16x8(RS + (size_t)row * VD + 16 * lane + 8, r[2], r[3]);
        float ss = 0.f;
#pragma unroll
        for (int j = 0; j < 4; ++j) ss += (o[j][0] * o[j][0] + o[j][1] * o[j][1]) + (o[j][2] * o[j][2] + o[j][3] * o[j][3]);
        ss += __shfl_xor(ss, 1); ss += __shfl_xor(ss, 2); ss += __shfl_xor(ss, 4); ss += __shfl_xor(ss, 8);
        const float rinv = rsqf_(ss * (1.0f / DV) + EPS);
#pragma unroll
        for (int j = 0; j < 4; ++j) o[j] = (o[j] * rinv * g[j]) * r[j];
        st_bf16x8(RS + (size_t)row * VD + 16 * lane, o[0], o[1]); st_bf16x8(RS + (size_t)row * VD + 16 * lane + 8, o[2], o[3]);
    }
}

__device__ __forceinline__ void p5_router(Frame& F) {
    LAS float* wr = (LAS float*)F.lds;
    LAS int* hist = (LAS int*)(F.lds + (NGRP + NE) * DM * 4);
    LAS int* base = hist + 32;
    LAS int* stash = hist + 64;
    { const u32x4* src = (const u32x4*)(F.ws + WS_WRT); for (int i = F.tid; i < (NGRP + NE) * DM / 4; i += NTHR) ((LAS u32x4*)wr)[i] = src[i]; }
    const float* mod = (const float*)(F.ws + WS_MOD);
    const float* Hh = F.out; bf16_t* U2 = (bf16_t*)(F.ws + WS_Q);
    int* lists = (int*)(F.ws + WS_LIST); int* tok = (int*)(F.ws + WS_TOK);
    const int lane = F.lane;
    float brg[NGRP];
#pragma unroll
    for (int j = 0; j < NGRP; ++j) brg[j] = F.in[IN_BRG][j];
    for (int rb = F.bid; rb < T / 64; rb += F.G) {
        if (F.tid < 32) hist[F.tid] = 0;
        __syncthreads();
        const int b = (rb * 64) / SEQ;
        const float* sh = mod + (size_t)b * NMOD * DM + 3 * DM; const float* sc = sh + DM;
        f32x4 vn[2][4];
#pragma unroll
        for (int q = 0; q < 2; ++q) { const f32x4* xr = (const f32x4*)(Hh + (size_t)(rb * 64 + F.wave * 8 + q) * DM) + lane;
#pragma unroll
            for (int j = 0; j < 4; ++j) vn[q][j] = xr[64 * j]; }
#pragma unroll 1
        for (int pp = 0; pp < 4; ++pp) {
            const int lr0 = F.wave * 8 + pp * 2, row0 = rb * 64 + lr0;
            f32x4 v[2][4]; float ss[2];
#pragma unroll
            for (int q = 0; q < 2; ++q)
#pragma unroll
                for (int j = 0; j < 4; ++j) v[q][j] = vn[q][j];
            if (pp < 3) {
#pragma unroll
                for (int q = 0; q < 2; ++q) { const f32x4* xr = (const f32x4*)(Hh + (size_t)(row0 + 2 + q) * DM) + lane;
#pragma unroll
                    for (int j = 0; j < 4; ++j) vn[q][j] = xr[64 * j]; } }
#pragma unroll
            for (int q = 0; q < 2; ++q) { float a = 0.f;
#pragma unroll
                for (int j = 0; j < 4; ++j) a += (v[q][j][0] * v[q][j][0] + v[q][j][1] * v[q][j][1]) + (v[q][j][2] * v[q][j][2] + v[q][j][3] * v[q][j][3]);
                ss[q] = a; }
            const float rinv0 = rsqf_(wave_sum(ss[0]) * (1.0f / DM) + EPS), rinv1 = rsqf_(wave_sum(ss[1]) * (1.0f / DM) + EPS);
#pragma unroll
            for (int j = 0; j < 4; ++j) { const int k = 4 * lane + 256 * j;
                const f32x4 g = *(const f32x4*)(F.in[IN_GN2] + k), s1 = *(const f32x4*)(sc + k) + 1.0f, s0 = *(const f32x4*)(sh + k);
                v[0][j] = (v[0][j] * rinv0 * g) * s1 + s0; v[1][j] = (v[1][j] * rinv1 * g) * s1 + s0; }
#pragma unroll
            for (int q = 0; q < 2; ++q) { u32x2* o8 = (u32x2*)(U2 + (size_t)(row0 + q) * DM) + lane;
#pragma unroll
                for (int j = 0; j < 4; ++j) { u32x2 w; w.x = cvt_pk_bf16(v[q][j][0], v[q][j][1]); w.y = cvt_pk_bf16(v[q][j][2], v[q][j][3]); o8[64 * j] = w; } }
            float lgg[2][NGRP];
#pragma unroll
            for (int i = 0; i < NGRP; ++i) { float s0 = 0.f, s1 = 0.f;
#pragma unroll
                for (int j = 0; j < 4; ++j) { const f32x4 w = *(const LAS f32x4*)(wr + i * DM + 4 * lane + 256 * j);
                    s0 += (v[0][j][0] * w[0] + v[0][j][1] * w[1]) + (v[0][j][2] * w[2] + v[0][j][3] * w[3]); s1 += (v[1][j][0] * w[0] + v[1][j][1] * w[1]) + (v[1][j][2] * w[2] + v[1][j][3] * w[3]); }
                lgg[0][i] = wave_sum(s0); lgg[1][i] = wave_sum(s1); }
#pragma unroll
            for (int q = 0; q < 2; ++q) {
                float gl[NGRP]; int gsel = 0;
#pragma unroll
                for (int j = 0; j < NGRP; ++j) gl[j] = lgg[q][j] + brg[j];
                float gmax = gl[0];
#pragma unroll
                for (int j = 1; j < NGRP; ++j) if (gl[j] > gmax) { gmax = gl[j]; gsel = j; }
                float den = 0.f;
#pragma unroll
                for (int j = 0; j < NGRP; ++j) den += __expf(gl[j] - gmax);
                const float wg = 1.0f / den;
                gsel = __builtin_amdgcn_readfirstlane(gsel);
                const LAS float* wre = wr + (NGRP + gsel * EPG) * DM + 4 * lane;
                float le[EPG];
#pragma unroll
                for (int j = 0; j < EPG; ++j) { float s0 = 0.f;
#pragma unroll
                    for (int jj = 0; jj < 4; ++jj) { const f32x4 w = *(const LAS f32x4*)(wre + j * DM + 256 * jj);
                        s0 += (v[q][jj][0] * w[0] + v[q][jj][1] * w[1]) + (v[q][jj][2] * w[2] + v[q][jj][3] * w[3]); }
                    le[j] = wave_sum(s0) + F.in[IN_BRE][gsel * EPG + j]; }
                int i0 = 0; float v0 = le[0];
#pragma unroll
                for (int j = 1; j < EPG; ++j) if (le[j] > v0) { v0 = le[j]; i0 = j; }
                int i1 = -1; float v1 = -3.0e38f;
#pragma unroll
                for (int j = 0; j < EPG; ++j) if (j != i0 && le[j] > v1) { v1 = le[j]; i1 = j; }
                const float e1 = __expf(v1 - v0); const float w0 = wg / (1.0f + e1), w1 = wg * e1 / (1.0f + e1);
                const int eid0 = gsel * EPG + i0, eid1 = gsel * EPG + i1;
                if (lane == 0) { const int r0 = atomicAdd((int*)(hist + eid0), 1), r1 = atomicAdd((int*)(hist + eid1), 1);
                    LAS int* st = stash + (lr0 + q) * 8; st[0] = eid0; st[1] = r0; st[2] = __float_as_int(w0); st[3] = eid1; st[4] = r1; st[5] = __float_as_int(w1); }
            }
        }
        __syncthreads();
        if (F.tid < 32) base[F.tid] = (int)atomicAdd(F.ctl + CW_CNT + F.tid, (unsigned)hist[F.tid]);
        __syncthreads();
        if (F.tid < 64) { const int row = rb * 64 + F.tid; const LAS int* st = stash + F.tid * 8;
            const int e0 = st[0], r0 = base[e0] + st[1], e1 = st[3], r1 = base[e1] + st[4];
            lists[(size_t)e0 * T + r0] = row; lists[(size_t)e1 * T + r1] = row;
            int* ti = tok + (size_t)row * 8; ti[0] = e0; ti[1] = r0; ti[2] = st[2]; ti[3] = e1; ti[4] = r1; ti[5] = st[5]; }
        __syncthreads();
    }
}

__device__ __forceinline__ void moe_table(Frame& F, LAS int* tbl) {
    if (F.tid < 64) { const int e = F.tid & 31;
        const int c = (int)__hip_atomic_load(F.ctl + CW_CNT + e, __ATOMIC_RELAXED, __HIP_MEMORY_SCOPE_AGENT);
        int incl = (c + 255) >> 8;
#pragma unroll
        for (int o = 1; o < 32; o <<= 1) { const int t = __shfl_up(incl, o, 32); if ((F.tid & 31) >= o) incl += t; }
        if (F.tid < 32) { tbl[e] = incl - ((c + 255) >> 8); tbl[40 + e] = c; if (e == 31) tbl[NE] = incl; } }
    __syncthreads();
}

__device__ __forceinline__ void p8_final(Frame& F) {
    LAS int* tbl = (LAS int*)(F.lds + TBL_OFF);
    moe_table(F, tbl);
    const float* mod = (const float*)(F.ws + WS_MOD); const float* modf = mod + BATCH * NMOD * DM;
    const bf16_t* Y = (const bf16_t*)(F.ws + WS_Y); const int* tok = (const int*)(F.ws + WS_TOK);
    const int gw = F.bid * NWAVES + F.wave, NGW = F.G * NWAVES, lane = F.lane;
    int tin[6]; f32x4 hn[4];
    if (gw < T) { const int* ti = tok + (size_t)gw * 8;
#pragma unroll
        for (int i = 0; i < 6; ++i) tin[i] = ti[i];
        const f32x4* hr = (const f32x4*)(F.out + (size_t)gw * DM) + lane;
#pragma unroll
        for (int j = 0; j < 4; ++j) hn[j] = hr[64 * j]; }
    for (int row = gw; row < T; row += NGW) {
        const int b = row / SEQ;
        const int e0 = tin[0], r0 = tin[1], e1 = tin[3], r1 = tin[4]; const float w0 = __int_as_float(tin[2]), w1 = __int_as_float(tin[5]);
        const size_t s0 = (size_t)tbl[e0] * 256 + r0, s1 = (size_t)tbl[e1] * 256 + r1;
        const u32x2* y0 = (const u32x2*)(Y + s0 * DM) + lane; const u32x2* y1 = (const u32x2*)(Y + s1 * DM) + lane;
        u32x2 ya[4], yc[4]; f32x4 hv[4];
#pragma unroll
        for (int j = 0; j < 4; ++j) { ya[j] = y0[64 * j]; yc[j] = y1[64 * j]; hv[j] = hn[j]; }
        if (row + NGW < T) { const int* ti = tok + (size_t)(row + NGW) * 8;
#pragma unroll
            for (int i = 0; i < 6; ++i) tin[i] = ti[i];
            const f32x4* hr = (const f32x4*)(F.out + (size_t)(row + NGW) * DM) + lane;
#pragma unroll
            for (int j = 0; j < 4; ++j) hn[j] = hr[64 * j]; }
        const float* ga = mod + (size_t)b * NMOD * DM + 5 * DM;
        f32x4 v[4]; float ss = 0.f;
#pragma unroll
        for (int j = 0; j < 4; ++j) { const int k = 4 * lane + 256 * j; const u32x2 a = ya[j], c = yc[j];
            const f32x4 fa = (f32x4){bflo(a.x), bfhi(a.x), bflo(a.y), bfhi(a.y)}, fc = (f32x4){bflo(c.x), bfhi(c.x), bflo(c.y), bfhi(c.y)};
            v[j] = hv[j] + *(const f32x4*)(ga + k) * (fa * w0 + fc * w1);
            ss += (v[j][0] * v[j][0] + v[j][1] * v[j][1]) + (v[j][2] * v[j][2] + v[j][3] * v[j][3]); }
        const float rinv = rsqf_(wave_sum(ss) * (1.0f / DM) + EPS);
        const float* sh = modf + (size_t)b * 2 * DM; const float* sc = sh + DM;
        f32x4* orow = (f32x4*)(F.out + (size_t)row * DM) + lane;
#pragma unroll
        for (int j = 0; j < 4; ++j) { const int k = 4 * lane + 256 * j;
            const f32x4 g = *(const f32x4*)(F.in[IN_GFIN] + k), s1v = *(const f32x4*)(sc + k), s0v = *(const f32x4*)(sh + k);
            orow[64 * j] = (v[j] * rinv * g) * (s1v + 1.0f) + s0v; }
    }
}

constexpr int NPHASE = 11;
struct Args { const float* in[28]; float* out; unsigned char* ws; int ph_lo, ph_hi; };
__global__ void __launch_bounds__(NTHR, 2) fwd_kernel(Args args) {
    extern __shared__ __attribute__((aligned(16))) unsigned char lds[];
    Frame F;
    F.lds = (LAS unsigned char*)lds;
    F.MISC = (volatile LAS unsigned*)(F.lds + MISC_OFF);
    F.tid = threadIdx.x; F.lane = F.tid & 63; F.wave = __builtin_amdgcn_readfirstlane(F.tid >> 6);
    F.G = gridDim.x; F.bid = blockIdx.x;
    F.ws = args.ws; F.out = args.out; F.ctl = (unsigned*)(args.ws + WS_CTL);
#pragma unroll
    for (int i = 0; i < 28; ++i) F.in[i] = args.in[i];
    if (F.tid < 128) F.MISC[F.tid] = 0u;
    __syncthreads();
    const int lo = args.ph_lo, hi = args.ph_hi;
    XcdBarrier bar; bar.bar = F.ctl + CW_BAR; bar.x = 0; bar.st = nullptr;
    if (hi - lo > 1) bar = xcd_barrier_post(F.ctl + CW_BAR, F.MISC + 8);
#define IN(k) (lo <= (k) && (k) < hi)
#if DIAG_A >= -1
    unsigned long long* const ts = (unsigned long long*)(F.ctl + 1024);
    if (F.bid == 0 && F.tid == 0) ts[0] = __builtin_amdgcn_s_memrealtime();
#define SEAM(k) do { if (IN(k) && IN((k) + 1)) xcd_barrier(bar); if (F.bid == 0 && F.tid == 0) ts[(k) + 1] = __builtin_amdgcn_s_memrealtime(); } while (0)
#else
#define SEAM(k) do { if (IN(k) && IN((k) + 1)) xcd_barrier(bar); } while (0)
#endif
    LAS unsigned char* ring = F.lds;

    for (int rep_ = 0; rep_ < ((DIAG_R == 0) ? 2 : 1); ++rep_) if (IN(0)) { p0_prologue(F); } SEAM(0);
    for (int rep_ = 0; rep_ < ((DIAG_R == 1) ? 2 : 1); ++rep_) if (IN(1)) { p1a_norm(F); } SEAM(1);
    for (int rep_ = 0; rep_ < ((DIAG_R == 2) ? 2 : 1); ++rep_) if (IN(2)) {
        pg8::DenseOrder S; S.init(F.ws + WS_U, F.ws + WS_WIN, T, NPROJ, DM, F.G, F.bid);
        EpiProj E{F.ws, (unsigned char*)F.out};
        pg8::gemm_phase<EpiProj, pg8::DenseOrder, false>(ring, DM, S, E);
    } SEAM(2);
    if (IN(3)) { p2_scan(F);
#if DIAG_A >= -1
        if (F.bid == 0 && F.tid == 0) ts[12] = __builtin_amdgcn_s_memrealtime();
#endif
        p2_conv(F); } SEAM(3);
    if (IN(4)) {
        p2c_gate(F);
        __syncthreads();
        pg8::DenseOrder S; S.init(F.ws + WS_Z2, F.ws + WS_WPW, T, DM, CONV_DIM, F.G, F.bid);
        EpiConvPw E{(bf16_t*)(F.ws + WS_U), (const bf16_t*)F.out, F.in[IN_BPW]};
        pg8::gemm_phase<EpiConvPw, pg8::DenseOrder, false>(ring, CONV_DIM, S, E);
    } SEAM(4);
    if (IN(5)) {
        pg8::DenseOrder S; S.init(F.ws + WS_RS, F.ws + WS_WGO, T, DM, VD, F.G, F.bid);
        EpiMerge E{(bf16_t*)(F.ws + WS_U), (const bf16_t*)F.out};
        pg8::gemm_phase<EpiMerge, pg8::DenseOrder, false>(ring, VD, S, E);
    } SEAM(5);
    for (int rep_ = 0; rep_ < ((DIAG_R == 6) ? 2 : 1); ++rep_) if (IN(6)) {
        pg8::DenseOrder S; S.init(F.ws + WS_U, F.ws + WS_WOUT, T, DM, DM, F.G, F.bid);
        EpiH E{F.in[IN_X], F.out, (const float*)(F.ws + WS_MOD)};
        pg8::gemm_phase<EpiH, pg8::DenseOrder, false>(ring, DM, S, E);
    } SEAM(6);
    if (IN(7)) { p5_router(F); } SEAM(7);
    for (int rep_ = 0; rep_ < ((DIAG_R == 8) ? 2 : 1); ++rep_) if (IN(8)) {
        LAS int* tbl = (LAS int*)(F.lds + TBL_OFF);
        moe_table(F, tbl);
        MoeOrder S; S.tstart = tbl; S.cnt = tbl + 40; S.G = F.G; S.c = F.bid; S.NT = 4; S.A = (const char*)(F.ws + WS_Q); S.W = (const char*)(F.ws + WS_W13);
        S.lists = (const int*)(F.ws + WS_LIST); S.wstride = (size_t)(2 * DE) * DM * 2; S.astride_tile = 0; S.wtile = (size_t)256 * DM * 2; S.gather = true;
        EpiUp E{(bf16_t*)(F.ws + WS_HID)};
        pg8::gemm_phase<EpiUp, MoeOrder, true>(ring, DM, S, E);
    } SEAM(8);
    for (int rep_ = 0; rep_ < ((DIAG_R == 9) ? 2 : 1); ++rep_) if (IN(9)) {
        LAS int* tbl = (LAS int*)(F.lds + TBL_OFF);
        moe_table(F, tbl);
        MoeOrder S; S.tstart = tbl; S.cnt = tbl + 40; S.G = F.G; S.c = F.bid; S.NT = 4; S.A = (const char*)(F.ws + WS_HID); S.W = (const char*)(F.ws + WS_W2);
        S.lists = nullptr; S.wstride = (size_t)DM * DE * 2; S.astride_tile = (size_t)256 * DE * 2; S.wtile = (size_t)256 * DE * 2; S.gather = false;
        EpiDown E{(bf16_t*)(F.ws + WS_Y)};
        pg8::gemm_phase<EpiDown, MoeOrder, false>(ring, DE, S, E);
    } SEAM(9);
    if (IN(10)) { p8_final(F); }
#if DIAG_A >= -1
    xcd_barrier(bar);
    if (F.bid == 0) {
        if (F.tid == 0) ts[11] = __builtin_amdgcn_s_memrealtime();
        __syncthreads();
        const float tot = (float)(ts[11] - ts[0]);
        const float fa = (DIAG_A == 30) ? (float)(ts[12] - ts[3]) / tot : (DIAG_A >= 0) ? (float)(ts[(DIAG_A >= 0 && DIAG_A < 11 ? DIAG_A : 0) + 1] - ts[(DIAG_A >= 0 && DIAG_A < 11 ? DIAG_A : 0)]) / tot : 1.0f;
        if (F.tid == 0) F.out[0] += 3.0f + 40.0f * fa;
    }
#endif
#undef IN
#undef SEAM
}

extern "C" void kernel_launch(void* const* d_in, const int* in_sizes, int n_in, void* d_out, int out_size, void* d_ws, size_t ws_size, hipStream_t stream) {
    static int grid = 0;
    if (grid == 0) {
        if (n_in != 28 || in_sizes[0] != T * DM || out_size != T * DM || ws_size < WS_END) {
            fprintf(stderr, "kernel_launch: shape / workspace mismatch (n_in %d, in0 %d, out %d, ws %zu, need %zu)\n", n_in, n_in > 0 ? in_sizes[0] : -1, out_size, ws_size, (size_t)WS_END); grid = -1; return; }
        int dev = 0, cus = 0, per_cu = 0;
        if (hipGetDevice(&dev) != hipSuccess || hipDeviceGetAttribute(&cus, hipDeviceAttributeMultiprocessorCount, dev) != hipSuccess) { grid = -1; return; }
        if (hipFuncSetAttribute((const void*)fwd_kernel, hipFuncAttributeMaxDynamicSharedMemorySize, LDS_BYTES) != hipSuccess) { fprintf(stderr, "kernel_launch: hipFuncSetAttribute failed\n"); grid = -1; return; }
        if (hipOccupancyMaxActiveBlocksPerMultiprocessor(&per_cu, (const void*)fwd_kernel, NTHR, LDS_BYTES) != hipSuccess || per_cu < 1) {
            fprintf(stderr, "kernel_launch: occupancy query reports %d workgroups per CU\n", per_cu); (void)hipGetLastError(); grid = -1; return; }
        grid = cus;
    }
    if (grid < 0) return;
    if (hipMemsetAsync((char*)d_ws + WS_CTL, 0, CTL_ZERO_BYTES, stream) != hipSuccess) return;
    Args a{};
    for (int i = 0; i < 28; ++i) a.in[i] = (const float*)d_in[i];
    a.out = (float*)d_out; a.ws = (unsigned char*)d_ws;
#if MK_N_LAUNCHES == 1
    a.ph_lo = 0; a.ph_hi = NPHASE;
    hipLaunchKernelGGL(fwd_kernel, dim3(grid), dim3(NTHR), LDS_BYTES, stream, a);
#else
    for (int p = 0; p < NPHASE; ++p) { a.ph_lo = p; a.ph_hi = p + 1; hipLaunchKernelGGL(fwd_kernel, dim3(grid), dim3(NTHR), LDS_BYTES, stream, a); }
#endif
}
```

```cpp
#include <hip/hip_runtime.h>
#include <cstdio>
#include <cstdint>

#ifndef MK_N_LAUNCHES
#define MK_N_LAUNCHES 1
#endif

#ifndef DIAG_A
#define DIAG_A -2
#endif
#ifndef DIAG_B
#define DIAG_B -1
#endif
#ifndef DIAG_R
#define DIAG_R -1
#endif
#define LAS __attribute__((address_space(3)))
#define GAS __attribute__((address_space(1)))
typedef unsigned short bf16_t;
typedef short bf16x8 __attribute__((ext_vector_type(8)));
typedef float f32x4 __attribute__((ext_vector_type(4)));
typedef float f32x2 __attribute__((ext_vector_type(2)));
typedef unsigned u32x4 __attribute__((ext_vector_type(4)));
typedef unsigned u32x2 __attribute__((ext_vector_type(2)));

constexpr int BATCH = 8, SEQ = 2048, DM = 1024, T = BATCH * SEQ;
constexpr int CONV_DIM = 512, CONV_W = 31, NH = 4, DK = 128, DV = 256, LOWRANK = 16, QKD = 512, VD = 1024;
constexpr int NE = 32, NGRP = 4, EPG = 8, DE = 512, NMOD = 6;
constexpr int IN_DIM = 6160, NPROJ = 6144;
constexpr float EPS = 1e-6f;
constexpr int SLOT_CAP = 2 * T + NE * 256;

constexpr size_t MiB = 1u << 20;
constexpr size_t WS_CTL = 0, CTL_ZERO_BYTES = 1 * MiB;
constexpr size_t WS_MOD = 1 * MiB;
constexpr size_t WS_WRT = WS_MOD + 256 * 1024;
constexpr size_t WS_WA1T = WS_MOD + 512 * 1024;
constexpr size_t WS_LIST = 2 * MiB;
constexpr size_t WS_TOK = 4 * MiB;
constexpr size_t WS_EBL = WS_TOK + 512 * 1024;
constexpr size_t WS_WPW = 5 * MiB, WS_WGO = 6 * MiB, WS_WOUT = 8 * MiB, WS_WIN = 10 * MiB;
constexpr size_t WS_W13 = 22 * MiB, WS_W2 = 86 * MiB;
constexpr size_t WS_U = 118 * MiB;
constexpr size_t WS_Q = 150 * MiB, WS_K = 166 * MiB;
constexpr size_t WS_V = 182 * MiB;
constexpr size_t WS_RS = 214 * MiB;
constexpr size_t WS_LG = 246 * MiB;
constexpr size_t WS_Z = 278 * MiB, WS_Z2 = 294 * MiB;
constexpr size_t WS_HID = WS_V;
constexpr size_t WS_Y = 222 * MiB;
constexpr size_t WS_END = 310 * MiB;
constexpr int CW_CNT = 64;
constexpr int CW_BAR = 4096;

constexpr int LDS_BYTES = 163840;
constexpr int RING_BYTES = 131072;
constexpr int MISC_OFF = LDS_BYTES - 512;
constexpr int TBL_OFF = RING_BYTES;

constexpr int NWAVES = 8, NTHR = 512;

__device__ __forceinline__ unsigned cvt_pk_bf16(float lo, float hi) { unsigned r; asm volatile("s_nop 0\n\tv_cvt_pk_bf16_f32 %0, %1, %2" : "=v"(r) : "v"(lo), "v"(hi)); return r; }
typedef __bf16 bf16x2_t __attribute__((ext_vector_type(2)));
__device__ __forceinline__ unsigned cvt_pk_bf16_c(float lo, float hi) { const f32x2 v = {lo, hi}; const bf16x2_t b = __builtin_convertvector(v, bf16x2_t); return __builtin_bit_cast(unsigned, b); }
__device__ __forceinline__ float bf2f(unsigned short b) { return __uint_as_float(((unsigned)b) << 16); }
__device__ __forceinline__ float bflo(unsigned w) { return __uint_as_float(w << 16); }
__device__ __forceinline__ float bfhi(unsigned w) { return __uint_as_float(w & 0xffff0000u); }
__device__ __forceinline__ float sigmoidf_(float x) { return __builtin_amdgcn_rcpf(1.0f + __expf(-x)); }
__device__ __forceinline__ float siluf_(float x) { return x * sigmoidf_(x); }
template <int CTRL, int RMASK> __device__ __forceinline__ float dpp_mov0(float v) { return __int_as_float(__builtin_amdgcn_update_dpp(0, __float_as_int(v), CTRL, RMASK, 0xf, false)); }
__device__ __forceinline__ float wave_red63(float v) {
    v += dpp_mov0<0x111, 0xf>(v); v += dpp_mov0<0x112, 0xf>(v); v += dpp_mov0<0x114, 0xf>(v); v += dpp_mov0<0x118, 0xf>(v);
    v += dpp_mov0<0x142, 0xa>(v); v += dpp_mov0<0x143, 0xc>(v); return v;
}
__device__ __forceinline__ float wave_sum(float v) { return __int_as_float(__builtin_amdgcn_readlane(__float_as_int(wave_red63(v)), 63)); }
__device__ __forceinline__ float rsqf_(float x) { return __builtin_amdgcn_rsqf(x); }
#define LDS_WAIT() asm volatile("s_waitcnt lgkmcnt(0)" ::: "memory")
#define VM_WAIT() asm volatile("s_waitcnt vmcnt(0)" ::: "memory")

namespace pg8 {
constexpr int BM = 256, BK = 64, HALF = 128, HTB = HALF * BK * 2, STAGE_BYTES = 8 * HTB, NXCD = 8, WGM = 8;
__host__ __device__ __forceinline__ int lds_byte(int r, int c) { const int st = (r >> 4) * 2 + (c >> 5), rr = r & 15, cc = c & 31, ob = rr * 64 + cc * 2; return st * 1024 + (ob ^ (((ob >> 9) & 1) << 5)); }
__host__ __device__ __forceinline__ void stage_rc(int b, int& R, int& C) { const int st = b / 1024, sb = b % 1024, swz = sb ^ (((sb >> 9) & 1) << 5); R = (st >> 1) * 16 + swz / 64; C = (st & 1) * 32 + (swz % 64) / 2; }
__host__ __device__ __forceinline__ int perm32(int rho) { const int n = rho >> 4, i = rho & 15; return 8 * (i >> 2) + 4 * n + (i & 3); }

struct Unit { int pm, pn; const char* pa; const char* pb; const int* rows; int nvalid; };

struct DenseOrder {
    const char* A; const char* Bt; int K, nM, nN, nwg, G, c;
    __device__ __forceinline__ void init(const void* A_, const void* Bt_, int M, int N, int K_, int G_, int c_) { A = (const char*)A_; Bt = (const char*)Bt_; K = K_; nM = M / BM; nN = N / BM; nwg = nM * nN; G = G_; c = c_; }
    __device__ __forceinline__ bool next(int i, Unit& u) const {
        const long L = (long)i * G + c; if (L >= nwg) return false;
        int wgid = (int)L; { const int q = nwg / NXCD, r = nwg % NXCD, xcd = wgid % NXCD, off = wgid / NXCD; wgid = (xcd < r ? xcd * (q + 1) : r * (q + 1) + (xcd - r) * q) + off; }
        const int nig = WGM * nN, gid = wgid / nig, fm = gid * WGM, gsz = (nM - fm) < WGM ? (nM - fm) : WGM;
        u.pm = fm + ((wgid % nig) % gsz); u.pn = (wgid % nig) / gsz;
        u.pa = A + (size_t)u.pm * BM * K * 2; u.pb = Bt + (size_t)u.pn * BM * K * 2; u.rows = nullptr; u.nvalid = 256; return true;
    }
};

template <class Epi, class Sched, bool GATHER>
__device__ __forceinline__ void gemm_phase(LAS unsigned char* lds, const int K, const Sched& S, const Epi& E) {
    const int tid = threadIdx.x, wid = __builtin_amdgcn_readfirstlane(tid >> 6), lane = tid & 63, wr = wid >> 2, wc = wid & 3, fr = lane & 15, fq = lane >> 4;
    const int nt = K / BK;
    unsigned voffA[2], voffB[2]; int rA[2]; unsigned cA2[2];
#pragma unroll
    for (int i = 0; i < 2; ++i) { int R, C; stage_rc(tid * 16 + i * 8192, R, C); const int Rb = Epi::PERM ? ((R & ~31) + perm32(R & 31)) : R;
        voffA[i] = (unsigned)(R * K + C) * 2u; voffB[i] = (unsigned)(Rb * K + C) * 2u; rA[i] = R; cA2[i] = (unsigned)C * 2u; }
    unsigned voffG[2][2] = {{0u, 0u}, {0u, 0u}}, voffGn[2][2] = {{0u, 0u}, {0u, 0u}};
    const size_t kstep = (size_t)(BK * 2);
    const size_t hstep = (size_t)HALF * K * 2;
    const unsigned ldsw = (unsigned)wid * 1024u;
    const int aoff = lds_byte(wr * 64 + fr, fq * 8), boff = lds_byte(wc * 32 + fr, fq * 8);
#define PG8_SA(b, h) (((b) * 2 + (h)) * HTB)
#define PG8_SB(b, h) ((4 + (b) * 2 + (h)) * HTB)
#define PG8_STAGE(bufoff, gbase, voff) do { _Pragma("unroll") for (int _i = 0; _i < 2; ++_i) \
        __builtin_amdgcn_global_load_lds((const unsigned*)((const char*)(gbase) + (voff)[_i]), (LAS unsigned*)(lds + (bufoff) + ldsw + _i * 8192), 16, 0, 0); } while (0)
#define PG8_STAGE_A(bufoff, kptr, h) do { if constexpr (GATHER) { PG8_STAGE(bufoff, kptr, voffG[h]); } else { PG8_STAGE(bufoff, (kptr) + (h) * hstep, voffA); } } while (0)
#define PG8_LDA(dst, b, h) do { _Pragma("unroll") for (int m = 0; m < 4; ++m) _Pragma("unroll") for (int k = 0; k < 2; ++k) dst[m][k] = *(const LAS bf16x8*)(lds + PG8_SA(b, h) + aoff + m * 2048 + k * 1024); } while (0)
#define PG8_LDB(dst, b, h) do { _Pragma("unroll") for (int n = 0; n < 2; ++n) _Pragma("unroll") for (int k = 0; k < 2; ++k) dst[n][k] = *(const LAS bf16x8*)(lds + PG8_SB(b, h) + boff + n * 2048 + k * 1024); } while (0)
#define PG8_MMA(ai, bj, At, Bt) do { __builtin_amdgcn_s_setprio(1); _Pragma("unroll") for (int m = 0; m < 4; ++m) _Pragma("unroll") for (int n = 0; n < 2; ++n) _Pragma("unroll") for (int k = 0; k < 2; ++k) \
        acc[ai][bj][m][n] = __builtin_amdgcn_mfma_f32_16x16x32_bf16(Bt[n][k], At[m][k], acc[ai][bj][m][n], 0, 0, 0); __builtin_amdgcn_s_setprio(0); } while (0)
#define PG8_WAIT_V(n) asm volatile("s_waitcnt vmcnt(" #n ")" ::: "memory")
#define PG8_WAIT_L(n) asm volatile("s_waitcnt lgkmcnt(" #n ")" ::: "memory")
#define PG8_BAR __builtin_amdgcn_s_barrier()
#define PG8_SCHED __builtin_amdgcn_sched_barrier(0)
#define PG8_LOADROWS(dst, u) do { _Pragma("unroll") for (int _h = 0; _h < 2; ++_h) _Pragma("unroll") for (int _i = 0; _i < 2; ++_i) { const int _r = _h * HALF + rA[_i]; \
        const int _idx = (_r < (u).nvalid) ? (u).rows[_r] : 0; dst[_h][_i] = (unsigned)_idx * (unsigned)(K * 2) + cA2[_i]; } } while (0)
    Unit cur, nxt; int ui = 0;
    if (!S.next(0, cur)) return;
    f32x4 acc[2][2][4][2];
#pragma unroll
    for (int a = 0; a < 2; ++a)
#pragma unroll
        for (int b = 0; b < 2; ++b)
#pragma unroll
            for (int m = 0; m < 4; ++m)
#pragma unroll
                for (int n = 0; n < 2; ++n) acc[a][b][m][n] = (f32x4){0.f, 0.f, 0.f, 0.f};
    bf16x8 At[4][2], B0[2][2], B1[2][2];
    const char* cA = cur.pa; const char* cB = cur.pb;
    if constexpr (GATHER) { PG8_LOADROWS(voffG, cur); }
    PG8_STAGE(PG8_SB(0, 0), cB, voffB); PG8_STAGE(PG8_SB(0, 1), cB + hstep, voffB); PG8_STAGE_A(PG8_SA(0, 0), cA, 0); PG8_STAGE_A(PG8_SA(0, 1), cA, 1);
    if (wr == 1) PG8_BAR;
    PG8_WAIT_V(2); PG8_BAR;
    PG8_STAGE(PG8_SB(1, 0), cB + kstep, voffB); PG8_STAGE_A(PG8_SA(1, 0), cA + kstep, 0); PG8_STAGE(PG8_SB(1, 1), cB + hstep + kstep, voffB);
    PG8_WAIT_V(6); PG8_BAR;
    for (;;) {
        const bool has_next = S.next(ui + 1, nxt);
        const char* nA = has_next ? nxt.pa : cA; const char* nB = has_next ? nxt.pb : cB;
        if constexpr (GATHER) { if (has_next) { PG8_LOADROWS(voffGn, nxt); } }
        for (int t = 0; t < nt; t += 2) {
            const bool last = (t == nt - 2);
            const char* a1 = cA + (size_t)(t + 1) * kstep;
            const char* a2 = last ? nA : cA + (size_t)(t + 2) * kstep; const char* b2 = last ? nB : cB + (size_t)(t + 2) * kstep;
            const char* a3 = a2 + kstep; const char* b3 = b2 + kstep;
            PG8_LDB(B0, 0, 0); PG8_LDB(B1, 0, 1); PG8_SCHED; PG8_LDA(At, 0, 0); PG8_STAGE_A(PG8_SA(1, 1), a1, 1);
            if constexpr (GATHER) { if (last && has_next) {
#pragma unroll
                for (int _h = 0; _h < 2; ++_h)
#pragma unroll
                    for (int _i = 0; _i < 2; ++_i) voffG[_h][_i] = voffGn[_h][_i]; } }
            PG8_WAIT_V(8); PG8_WAIT_L(0); PG8_BAR; PG8_MMA(0, 0, At, B0); PG8_MMA(0, 1, At, B1); PG8_BAR; PG8_SCHED;
            PG8_LDA(At, 0, 1); PG8_STAGE(PG8_SB(0, 0), b2, voffB); PG8_STAGE(PG8_SB(0, 1), b2 + hstep, voffB); PG8_STAGE_A(PG8_SA(0, 0), a2, 0);
            PG8_WAIT_V(8); PG8_WAIT_L(0); PG8_BAR; PG8_MMA(1, 0, At, B0); PG8_MMA(1, 1, At, B1); PG8_BAR; PG8_SCHED;
            PG8_LDB(B0, 1, 0); PG8_LDB(B1, 1, 1); PG8_SCHED; PG8_LDA(At, 1, 0); PG8_STAGE_A(PG8_SA(0, 1), a2, 1);
            PG8_WAIT_V(8); PG8_WAIT_L(0); PG8_BAR; PG8_MMA(0, 0, At, B0); PG8_MMA(0, 1, At, B1); PG8_BAR; PG8_SCHED;
            PG8_LDA(At, 1, 1); PG8_STAGE(PG8_SB(1, 0), b3, voffB); PG8_STAGE(PG8_SB(1, 1), b3 + hstep, voffB); PG8_STAGE_A(PG8_SA(1, 0), a3, 0);
            PG8_WAIT_V(8); PG8_WAIT_L(0); PG8_BAR; PG8_MMA(1, 0, At, B0); PG8_MMA(1, 1, At, B1); PG8_BAR; PG8_SCHED;
        }
        if (wr == 0) PG8_BAR;
        E(acc, cur, wr, wc, fr, fq);
        if (!has_next) break;
#pragma unroll
        for (int a = 0; a < 2; ++a)
#pragma unroll
            for (int b = 0; b < 2; ++b)
#pragma unroll
                for (int m = 0; m < 4; ++m)
#pragma unroll
                    for (int n = 0; n < 2; ++n) acc[a][b][m][n] = (f32x4){0.f, 0.f, 0.f, 0.f};
        cur = nxt; cA = nA; cB = nB; ++ui;
        if (wr == 1) PG8_BAR;
    }
    PG8_WAIT_V(0);
    PG8_BAR;
#undef PG8_SA
#undef PG8_SB
#undef PG8_STAGE
#undef PG8_STAGE_A
#undef PG8_LDA
#undef PG8_LDB
#undef PG8_MMA
#undef PG8_WAIT_V
#undef PG8_WAIT_L
#undef PG8_BAR
#undef PG8_SCHED
#undef PG8_LOADROWS
}
}

#define XB_TMO      128
#define XB_XCNT(j)  (256  + 64 * (j))
#define XB_XSUB(j)  (1280 + 64 * (j))
#define XB_XGEN(j)  (2304 + 64 * (j))
#define XB_TOP      3328
#define XB_TOPGEN   3392
#define XCD_BAR_WORDS 3456
#define XB_SPIN_CAP (1u << 18)
__device__ __forceinline__ unsigned xb_ld(unsigned* p)              { return __hip_atomic_load(p, __ATOMIC_RELAXED, __HIP_MEMORY_SCOPE_AGENT); }
__device__ __forceinline__ unsigned xb_add(unsigned* p, unsigned v) { return __hip_atomic_fetch_add(p, v, __ATOMIC_RELAXED, __HIP_MEMORY_SCOPE_AGENT); }
__device__ __forceinline__ unsigned xb_xcc_id() { return (unsigned)__builtin_amdgcn_s_getreg((3 << 11) | 20) & 0xFu; }
#define XB_SPIN(cond, bar) do { unsigned _sp = 0; while (cond) { __builtin_amdgcn_s_sleep(1); \
    if ((++_sp & 255u) == 0u) { if (xb_ld(&(bar)[XB_TMO])) break; if (_sp > XB_SPIN_CAP) { atomicAdd(&(bar)[XB_TMO], 1u); break; } } } } while (0)
struct XcdBarrier { unsigned* bar; unsigned x; volatile LAS unsigned* st; };
__device__ __forceinline__ XcdBarrier xcd_barrier_post(unsigned* bar, volatile LAS unsigned* st) {
    XcdBarrier b; b.bar = bar; b.x = xb_xcc_id(); b.st = st;
    if (threadIdx.x == 0) (void)xb_add(&bar[XB_XCNT(b.x)], 1u);
    return b;
}
__device__ __forceinline__ void xcd_barrier_complete(unsigned* bar, unsigned x, unsigned& nloc, unsigned& nx) {
    const unsigned G = gridDim.x * gridDim.y * gridDim.z;
    unsigned sum, cnt, mine, sp = 0u;
    for (;;) {
        sum = 0u; cnt = 0u; mine = 0u;
#pragma unroll
        for (unsigned j = 0; j < 16; ++j) { const unsigned c = xb_ld(&bar[XB_XCNT(j)]); sum += c; cnt += (c > 0u) ? 1u : 0u; mine = (j == x) ? c : mine; }
        if (sum == G) break;
        __builtin_amdgcn_s_sleep(1);
        if ((++sp & 255u) == 0u) { if (xb_ld(&bar[XB_TMO])) break; if (sp > XB_SPIN_CAP) { atomicAdd(&bar[XB_TMO], 1u); break; } }
    }
    nloc = mine > 0u ? mine : 1u; nx = cnt > 0u ? cnt : 1u;
}
__device__ __forceinline__ void xcd_barrier(const XcdBarrier& b) {
    asm volatile("s_waitcnt vmcnt(0)" ::: "memory");
    __syncthreads();
    if (threadIdx.x == 0) {
        unsigned* bar = b.bar;
        __builtin_amdgcn_s_waitcnt(0);
        unsigned nloc = b.st[0], nx = b.st[1];
        if (nloc == 0u) { xcd_barrier_complete(bar, b.x, nloc, nx); b.st[0] = nloc; b.st[1] = nx; }
        const unsigned old = xb_add(&bar[XB_XSUB(b.x)], 1u);
        const unsigned gen = old / nloc;
        if (old + 1u == (gen + 1u) * nloc) {
            __builtin_amdgcn_fence(__ATOMIC_RELEASE, "agent");
            asm volatile("s_waitcnt vmcnt(0)" ::: "memory");
            const unsigned og = xb_add(&bar[XB_TOP], 1u);
            const unsigned tg = og / nx;
            if (og + 1u == (tg + 1u) * nx) xb_add(&bar[XB_TOPGEN], 1u);
            else XB_SPIN(xb_ld(&bar[XB_TOPGEN]) == tg, bar);
            __builtin_amdgcn_fence(__ATOMIC_ACQUIRE, "agent");
            xb_add(&bar[XB_XGEN(b.x)], 1u);
            asm volatile("s_waitcnt vmcnt(0)" ::: "memory");
        } else {
            XB_SPIN(xb_ld(&bar[XB_XGEN(b.x)]) == gen, bar);
            __builtin_amdgcn_fence(__ATOMIC_ACQUIRE, "agent");
            asm volatile("s_waitcnt vmcnt(0)" ::: "memory");
        }
    }
    __syncthreads();
}

struct Frame {
    LAS unsigned char* lds;
    volatile LAS unsigned* MISC;
    unsigned* ctl;
    int tid, lane, wave, G, bid;
    const float* in[28]; float* out; unsigned char* ws;
};
#define IN_X 0
#define IN_C 1
#define IN_WADA 2
#define IN_BADA 3
#define IN_GN1 4
#define IN_WIN 5
#define IN_WDW 6
#define IN_BDW 7
#define IN_GCLN 8
#define IN_BCLN 9
#define IN_WPW 10
#define IN_BPW 11
#define IN_WA2 12
#define IN_BA2 13
#define IN_GGLA 14
#define IN_WGO 15
#define IN_WOUT 16
#define IN_GN2 17
#define IN_WRG 18
#define IN_BRG 19
#define IN_WRE 20
#define IN_BRE 21
#define IN_W1 22
#define IN_W3 23
#define IN_W2 24
#define IN_WADAF 25
#define IN_BADAF 26
#define IN_GFIN 27

__device__ __forceinline__ void st_bf16x8(bf16_t* p, f32x4 v0, f32x4 v1) {
    u32x4 w; w.x = cvt_pk_bf16(v0[0], v0[1]); w.y = cvt_pk_bf16(v0[2], v0[3]); w.z = cvt_pk_bf16(v1[0], v1[1]); w.w = cvt_pk_bf16(v1[2], v1[3]);
    *(u32x4*)p = w;
}
__device__ __forceinline__ void ld_bf16x8(const bf16_t* p, f32x4& v0, f32x4& v1) {
    const u32x4 w = *(const u32x4*)p;
    v0 = (f32x4){bflo(w.x), bfhi(w.x), bflo(w.y), bfhi(w.y)}; v1 = (f32x4){bflo(w.z), bfhi(w.z), bflo(w.w), bfhi(w.w)};
}
__device__ __forceinline__ f32x4 sig4(f32x4 v) { return (f32x4){sigmoidf_(v[0]), sigmoidf_(v[1]), sigmoidf_(v[2]), sigmoidf_(v[3])}; }
__device__ __forceinline__ f32x4 silu4(f32x4 v) { return (f32x4){siluf_(v[0]), siluf_(v[1]), siluf_(v[2]), siluf_(v[3])}; }

struct EpiProj {
    static constexpr bool PERM = true;
    unsigned char* ws; unsigned char* outp;
    __device__ __forceinline__ void operator()(const f32x4 (&acc)[2][2][4][2], const pg8::Unit& u, int wr, int wc, int fr, int fq) const {
        const int row0 = u.pm * 256 + wr * 64 + fr, c8 = wc * 32 + 8 * fq, pn = u.pn;
        if (pn < 4) {
            bf16_t* Z = (bf16_t*)(ws + WS_Z);
#pragma unroll
            for (int ai = 0; ai < 2; ++ai)
#pragma unroll
                for (int m = 0; m < 4; ++m) { const int row = row0 + ai * 128 + m * 16;
                    const f32x4 z0 = acc[ai][0][m][0] * sig4(acc[ai][1][m][0]), z1 = acc[ai][0][m][1] * sig4(acc[ai][1][m][1]);
                    st_bf16x8(Z + (size_t)row * CONV_DIM + 128 * pn + c8, z0, z1); }
        } else {
            if (pn < 8) {
                const bool isq = pn < 6; const int colq = ((pn - 4) & 1) * 256;
                bf16_t* base = (bf16_t*)(ws + (isq ? WS_Q : WS_K)); const bf16_t* FQ = (const bf16_t*)(ws + WS_LG);
#pragma unroll
                for (int ai = 0; ai < 2; ++ai)
#pragma unroll
                    for (int m = 0; m < 4; ++m) { const int row = row0 + ai * 128 + m * 16;
#pragma unroll
                        for (int bj = 0; bj < 2; ++bj) { const int col = colq + bj * 128 + c8;
                            f32x4 f0, f1; ld_bf16x8(FQ + (size_t)row * QKD + col, f0, f1);
                            if (!isq) { f0 = (f32x4){__builtin_amdgcn_rcpf(f0[0]), __builtin_amdgcn_rcpf(f0[1]), __builtin_amdgcn_rcpf(f0[2]), __builtin_amdgcn_rcpf(f0[3])};
                                        f1 = (f32x4){__builtin_amdgcn_rcpf(f1[0]), __builtin_amdgcn_rcpf(f1[1]), __builtin_amdgcn_rcpf(f1[2]), __builtin_amdgcn_rcpf(f1[3])}; }
                            st_bf16x8(base + (size_t)row * QKD + col, acc[ai][bj][m][0] * f0, acc[ai][bj][m][1] * f1); } }
                return;
            }
            int ld, col0, act; size_t boff;
            if (pn < 16) { ld = VD; col0 = ((pn - 8) & 3) * 256; boff = WS_V + (size_t)((pn - 8) >> 2) * (WS_RS - WS_V); act = (pn >= 12) ? 1 : 0; }
            else { ld = 2 * DM; col0 = (pn - 16) * 256; boff = 0; act = 2; }
            bf16_t* base = (bf16_t*)(((pn >= 16) ? outp : ws) + boff);
#pragma unroll
            for (int ai = 0; ai < 2; ++ai)
#pragma unroll
                for (int m = 0; m < 4; ++m) { const int row = row0 + ai * 128 + m * 16;
#pragma unroll
                    for (int bj = 0; bj < 2; ++bj) { f32x4 v0 = acc[ai][bj][m][0], v1 = acc[ai][bj][m][1];
                        if (act == 1) { v0 = silu4(v0); v1 = silu4(v1); } else if (act == 2) { v0 = sig4(v0); v1 = sig4(v1); }
                        st_bf16x8(base + (size_t)row * ld + col0 + bj * 128 + c8, v0, v1); } }
        }
    }
};
struct EpiConvPw {
    static constexpr bool PERM = true;
    bf16_t* M1; const bf16_t* Gt; const float* bias;
    __device__ __forceinline__ void operator()(const f32x4 (&acc)[2][2][4][2], const pg8::Unit& u, int wr, int wc, int fr, int fq) const {
        const int row0 = u.pm * 256 + wr * 64 + fr, col0 = u.pn * 256 + wc * 32 + 8 * fq;
#pragma unroll
        for (int bj = 0; bj < 2; ++bj) { const int col = col0 + bj * 128;
            const f32x4 b0 = *(const f32x4*)(bias + col), b1 = *(const f32x4*)(bias + col + 4);
#pragma unroll
            for (int ai = 0; ai < 2; ++ai)
#pragma unroll
                for (int m = 0; m < 4; ++m) { const int row = row0 + ai * 128 + m * 16;
                    f32x4 g0, g1; ld_bf16x8(Gt + (size_t)row * (2 * DM) + col, g0, g1);
                    st_bf16x8(M1 + (size_t)row * DM + col, g0 * (acc[ai][bj][m][0] + b0), g1 * (acc[ai][bj][m][1] + b1)); } }
    }
};
struct EpiMerge {
    static constexpr bool PERM = true;
    bf16_t* M1; const bf16_t* Gt;
    __device__ __forceinline__ void operator()(const f32x4 (&acc)[2][2][4][2], const pg8::Unit& u, int wr, int wc, int fr, int fq) const {
        const int row0 = u.pm * 256 + wr * 64 + fr, col0 = u.pn * 256 + wc * 32 + 8 * fq;
#pragma unroll
        for (int ai = 0; ai < 2; ++ai)
#pragma unroll
            for (int m = 0; m < 4; ++m) { const int row = row0 + ai * 128 + m * 16;
#pragma unroll
                for (int bj = 0; bj < 2; ++bj) { const int col = col0 + bj * 128;
                    f32x4 g0, g1, p0, p1; ld_bf16x8(Gt + (size_t)row * (2 * DM) + DM + col, g0, g1); ld_bf16x8(M1 + (size_t)row * DM + col, p0, p1);
                    st_bf16x8(M1 + (size_t)row * DM + col, p0 + g0 * acc[ai][bj][m][0], p1 + g1 * acc[ai][bj][m][1]); } }
    }
};
struct EpiH {
    static constexpr bool PERM = false;
    const float* x; float* Hout; const float* mod;
    __device__ __forceinline__ void operator()(const f32x4 (&acc)[2][2][4][2], const pg8::Unit& u, int wr, int wc, int fr, int fq) const {
        const int row0 = u.pm * 256 + wr * 64 + fr, col0 = u.pn * 256 + wc * 32 + 4 * fq;
        const int b = (u.pm * 256) / SEQ;
        f32x4 ga[2][2];
#pragma unroll
        for (int bj = 0; bj < 2; ++bj)
#pragma unroll
            for (int n = 0; n < 2; ++n) ga[bj][n] = *(const f32x4*)(mod + (size_t)b * (NMOD * DM) + 2 * DM + col0 + bj * 128 + n * 16);
#pragma unroll
        for (int ai = 0; ai < 2; ++ai)
#pragma unroll
            for (int m = 0; m < 4; ++m) { const size_t off = (size_t)(row0 + ai * 128 + m * 16) * DM + col0;
#pragma unroll
                for (int bj = 0; bj < 2; ++bj)
#pragma unroll
                    for (int n = 0; n < 2; ++n) { const f32x4 xv = *(const f32x4*)(x + off + bj * 128 + n * 16);
                        *(f32x4*)(Hout + off + bj * 128 + n * 16) = xv + ga[bj][n] * acc[ai][bj][m][n]; } }
    }
};
struct EpiUp {
    static constexpr bool PERM = true;
    bf16_t* HID;
    __device__ __forceinline__ void operator()(const f32x4 (&acc)[2][2][4][2], const pg8::Unit& u, int wr, int wc, int fr, int fq) const {
        const int row0 = u.pm * 256 + wr * 64 + fr, col = u.pn * 128 + wc * 32 + 8 * fq;
#pragma unroll
        for (int ai = 0; ai < 2; ++ai)
#pragma unroll
            for (int m = 0; m < 4; ++m) { const int row = row0 + ai * 128 + m * 16;
                st_bf16x8(HID + (size_t)row * DE + col, silu4(acc[ai][0][m][0]) * acc[ai][1][m][0], silu4(acc[ai][0][m][1]) * acc[ai][1][m][1]); }
    }
};
struct EpiDown {
    static constexpr bool PERM = true;
    bf16_t* Y;
    __device__ __forceinline__ void operator()(const f32x4 (&acc)[2][2][4][2], const pg8::Unit& u, int wr, int wc, int fr, int fq) const {
        const int row0 = u.pm * 256 + wr * 64 + fr, col0 = u.pn * 256 + wc * 32 + 8 * fq;
#pragma unroll
        for (int ai = 0; ai < 2; ++ai)
#pragma unroll
            for (int m = 0; m < 4; ++m) { const int row = row0 + ai * 128 + m * 16;
#pragma unroll
                for (int bj = 0; bj < 2; ++bj) st_bf16x8(Y + (size_t)row * DM + col0 + bj * 128, acc[ai][bj][m][0], acc[ai][bj][m][1]); }
    }
};

struct MoeOrder {
    const LAS int* tstart; const LAS int* cnt; int G, c, NT;
    const char* A; const char* W; const int* lists; size_t wstride, astride_tile, wtile;
    bool gather;
    __device__ __forceinline__ bool next(int i, pg8::Unit& u) const {
        const int L = i * G + c; const int ntile = tstart[NE];
        if (L >= ntile * NT) return false;
        const int mt = L / NT, pn = L % NT;
        int e = 0;
#pragma unroll 1
        while (e < NE - 1 && tstart[e + 1] <= mt) ++e;
        const int lt = mt - tstart[e];
        u.pm = mt; u.pn = pn;
        u.pb = W + (size_t)e * wstride + (size_t)pn * wtile;
        if (gather) { u.pa = A; u.rows = lists + (size_t)e * T + lt * 256; const int rem = cnt[e] - lt * 256; u.nvalid = rem < 256 ? rem : 256; }
        else { u.pa = A + (size_t)mt * astride_tile; u.rows = nullptr; u.nvalid = 256; }
        return true;
    }
};

struct TrItem { const float* W; int ldw, k0, n0; bf16_t* D; int K, drow0; float scale; };
__device__ __forceinline__ void tr_load(const TrItem& t, float (&v)[32], int lane) {
#pragma unroll
    for (int i = 0; i < 32; ++i) v[i] = t.W[(size_t)(t.k0 + 2 * i + (lane >> 5)) * t.ldw + t.n0 + (lane & 31)];
}
__device__ __forceinline__ void tr_finish(const TrItem& t, const float (&v)[32], LAS float* scr, int lane) {
#pragma unroll
    for (int i = 0; i < 32; ++i) scr[(2 * i + (lane >> 5)) * 33 + (lane & 31)] = v[i];
    LDS_WAIT(); asm volatile("" ::: "memory");
    const int c = lane & 7; const float scale = t.scale;
#pragma unroll
    for (int j = 0; j < 4; ++j) { const int n = (lane >> 3) + 8 * j; const LAS float* s = scr + (8 * c) * 33 + n;
        u32x4 o; o.x = cvt_pk_bf16(s[0 * 33] * scale, s[1 * 33] * scale); o.y = cvt_pk_bf16(s[2 * 33] * scale, s[3 * 33] * scale);
        o.z = cvt_pk_bf16(s[4 * 33] * scale, s[5 * 33] * scale); o.w = cvt_pk_bf16(s[6 * 33] * scale, s[7 * 33] * scale);
        *(u32x4*)(t.D + (size_t)(t.drow0 + n) * t.K + t.k0 + 8 * c) = o; }
    LDS_WAIT(); asm volatile("" ::: "memory");
}
constexpr int P0_I_IN = (NPROJ / 32) * (DM / 64), P0_I_PW = (DM / 32) * (CONV_DIM / 64), P0_I_GO = (DM / 32) * (VD / 64), P0_I_OUT = (DM / 32) * (DM / 64);
constexpr int P0_I_13E = (2 * DE / 32) * (DM / 64), P0_I_2E = (DM / 32) * (DE / 64);
constexpr int P0_NITEMS = P0_I_IN + P0_I_PW + P0_I_GO + P0_I_OUT + NE * P0_I_13E + NE * P0_I_2E;
__device__ __forceinline__ TrItem tr_decode(const Frame& F, int it) {
    TrItem t; int r = it; t.scale = 1.f;
    if (r < P0_I_IN) { const int nb = r / 16, kb = r % 16, d0 = nb * 32; int src;
        if (d0 < 1024) { const int j = d0 >> 8, w = d0 & 255; src = (w < 128) ? (128 * j + w) : (512 + 128 * j + (w - 128)); }
        else if (d0 < 4096) { src = d0; if (d0 < 1536) t.scale = 0.08838834764831845f; }
        else src = d0 + 16;
        t.W = F.in[IN_WIN]; t.ldw = IN_DIM; t.k0 = kb * 64; t.n0 = src; t.D = (bf16_t*)(F.ws + WS_WIN); t.K = DM; t.drow0 = d0; return t; }
    r -= P0_I_IN;
    if (r < P0_I_PW) { const int nb = r / 8, kb = r % 8; t.W = F.in[IN_WPW]; t.ldw = DM; t.k0 = kb * 64; t.n0 = nb * 32; t.D = (bf16_t*)(F.ws + WS_WPW); t.K = CONV_DIM; t.drow0 = nb * 32; return t; }
    r -= P0_I_PW;
    if (r < P0_I_GO) { const int nb = r / 16, kb = r % 16; t.W = F.in[IN_WGO]; t.ldw = DM; t.k0 = kb * 64; t.n0 = nb * 32; t.D = (bf16_t*)(F.ws + WS_WGO); t.K = VD; t.drow0 = nb * 32; return t; }
    r -= P0_I_GO;
    if (r < P0_I_OUT) { const int nb = r / 16, kb = r % 16; t.W = F.in[IN_WOUT]; t.ldw = DM; t.k0 = kb * 64; t.n0 = nb * 32; t.D = (bf16_t*)(F.ws + WS_WOUT); t.K = DM; t.drow0 = nb * 32; return t; }
    r -= P0_I_OUT;
    if (r < NE * P0_I_13E) { const int e = r / P0_I_13E, q = r % P0_I_13E, nb = q / 16, kb = q % 16, d0 = nb * 32, pp = d0 >> 8, w = d0 & 255;
        t.W = ((w < 128) ? F.in[IN_W1] : F.in[IN_W3]) + (size_t)e * DM * DE; t.ldw = DE; t.k0 = kb * 64; t.n0 = 128 * pp + (w & 127);
        t.D = (bf16_t*)(F.ws + WS_W13) + (size_t)e * (2 * DE) * DM; t.K = DM; t.drow0 = d0; return t; }
    r -= NE * P0_I_13E;
    { const int e = r / P0_I_2E, q = r % P0_I_2E, nb = q / 8, kb = q % 8;
        t.W = F.in[IN_W2] + (size_t)e * DE * DM; t.ldw = DM; t.k0 = kb * 64; t.n0 = nb * 32; t.D = (bf16_t*)(F.ws + WS_W2) + (size_t)e * DM * DE; t.K = DE; t.drow0 = nb * 32; return t; }
}
__device__ __forceinline__ void p0_prologue(Frame& F) {
    {
        LAS float* cact = (LAS float*)F.lds;
        LAS float* red = (LAS float*)(F.lds + 32768);
        const float* c = F.in[IN_C];
        for (int i = F.tid; i < BATCH * DM; i += NTHR) cact[i] = siluf_(c[i]);
        __syncthreads();
        float* mod = (float*)(F.ws + WS_MOD); float* modf = mod + BATCH * NMOD * DM;
        for (int cb = F.bid; cb < 256; cb += F.G) {
            const int j0 = cb * 32, col = F.tid & 31, kq = F.tid >> 5;
            const bool isf = j0 >= NMOD * DM;
            const float* W = isf ? F.in[IN_WADAF] : F.in[IN_WADA]; const int ldw = isf ? 2 * DM : NMOD * DM; const int jj = isf ? j0 - NMOD * DM : j0;
            float a[8];
#pragma unroll
            for (int b = 0; b < 8; ++b) a[b] = 0.f;
#pragma unroll 1
            for (int k0 = kq * 64; k0 < kq * 64 + 64; k0 += 16) { float w[16];
#pragma unroll
                for (int u = 0; u < 16; ++u) w[u] = W[(size_t)(k0 + u) * ldw + jj + col];
#pragma unroll
                for (int u = 0; u < 16; ++u)
#pragma unroll
                    for (int b = 0; b < 8; ++b) a[b] += cact[b * DM + k0 + u] * w[u]; }
#pragma unroll
            for (int b = 0; b < 8; ++b) red[(kq * 8 + b) * 32 + col] = a[b];
            __syncthreads();
            if (F.tid < 256) { const int b = F.tid >> 5; float s = 0.f;
#pragma unroll
                for (int q = 0; q < 16; ++q) s += red[(q * 8 + b) * 32 + col];
                if (isf) modf[b * 2 * DM + jj + col] = s + F.in[IN_BADAF][jj + col]; else mod[b * NMOD * DM + jj + col] = s + F.in[IN_BADA][jj + col]; }
            __syncthreads();
        }
    }
    {
        float* wrt = (float*)(F.ws + WS_WRT); bf16_t* wa1t = (bf16_t*)(F.ws + WS_WA1T);
        for (int it = F.bid; it < NGRP + NE + LOWRANK; it += F.G)
            for (int k = F.tid; k < DM; k += NTHR) {
                if (it < NGRP) wrt[it * DM + k] = F.in[IN_WRG][k * NGRP + it];
                else if (it < NGRP + NE) wrt[it * DM + k] = F.in[IN_WRE][k * NE + (it - NGRP)];
                else { const int j = it - NGRP - NE; const float w = F.in[IN_WIN][(size_t)k * IN_DIM + 4096 + j];
                    const unsigned hi = cvt_pk_bf16(w, 0.f) & 0xffffu; const float rem = w - bf2f((unsigned short)hi);
                    wa1t[j * DM + k] = (bf16_t)hi; wa1t[LOWRANK * DM + j * DM + k] = (bf16_t)(cvt_pk_bf16(rem, 0.f) & 0xffffu); }
            }
    }
    LAS float* scr = (LAS float*)(F.lds + F.wave * 16384);
    const int gw = F.bid * NWAVES + F.wave, NGW = F.G * NWAVES;
    float va[32], vb[32];
    int it = gw;
    TrItem ta, tb;
    if (it < P0_NITEMS) { ta = tr_decode(F, it); tr_load(ta, va, F.lane); }
#pragma unroll 1
    while (it < P0_NITEMS) {
        const int it1 = it + NGW;
        if (it1 < P0_NITEMS) { tb = tr_decode(F, it1); tr_load(tb, vb, F.lane); }
        tr_finish(ta, va, scr, F.lane);
        if (it1 >= P0_NITEMS) break;
        const int it2 = it1 + NGW;
        if (it2 < P0_NITEMS) { ta = tr_decode(F, it2); tr_load(ta, va, F.lane); }
        tr_finish(tb, vb, scr, F.lane);
        it = it2;
    }
}

__device__ __forceinline__ void p1a_norm(Frame& F) {
    constexpr int WSTR = 2064;
    constexpr int OFF_W1H = 0, OFF_W1L = 16 * WSTR, OFF_WA2 = 32 * WSTR, OFF_A1T = OFF_WA2 + LOWRANK * QKD * 4, OFF_UST = OFF_A1T + 64 * LOWRANK * 4, OFF_TOT = OFF_UST + NWAVES * 2 * WSTR, OFF_END = OFF_TOT + 512 * 8;
    static_assert(OFF_END <= MISC_OFF, "p1a LDS");
    LAS unsigned char* L = F.lds;
    { const u32x4* s1 = (const u32x4*)(F.ws + WS_WA1T);
      for (int i = F.tid; i < 2 * LOWRANK * DM / 8; i += NTHR) { const int r = i >> 7, c16 = i & 127; *(LAS u32x4*)(L + OFF_W1H + r * WSTR + c16 * 16) = s1[i]; }
      const u32x4* s2 = (const u32x4*)F.in[IN_WA2];
      for (int i = F.tid; i < LOWRANK * QKD / 4; i += NTHR) ((LAS u32x4*)(L + OFF_WA2))[i] = s2[i]; }
    __syncthreads();
#if DIAG_A >= -1
    if (F.bid == 0 && F.tid == 0) ((unsigned long long*)(F.ctl + 1024))[13] = __builtin_amdgcn_s_memrealtime();
#endif
    const float* mod = (const float*)(F.ws + WS_MOD);
    bf16_t* U = (bf16_t*)(F.ws + WS_U); bf16_t* FQ = (bf16_t*)(F.ws + WS_LG); float* EBL = (float*)(F.ws + WS_EBL);
    const int lane = F.lane, wave = F.wave, n16 = lane & 15, g = lane >> 4;
    LAS unsigned char* ust = L + OFF_UST + wave * 2 * WSTR;
    for (int cb = F.bid; cb < T / 64; cb += F.G) {
        const int b = (cb * 64) / SEQ;
        const float* sh = mod + (size_t)b * NMOD * DM; const float* sc = sh + DM;
        f32x4 mscale[4], mshift[4];
#pragma unroll
        for (int j = 0; j < 4; ++j) { const int k = 4 * lane + 256 * j; mscale[j] = *(const f32x4*)(F.in[IN_GN1] + k) * (*(const f32x4*)(sc + k) + 1.0f); mshift[j] = *(const f32x4*)(sh + k); }
        f32x4 vn[2][4];
#pragma unroll
        for (int q = 0; q < 2; ++q) { const f32x4* xr = (const f32x4*)(F.in[IN_X] + (size_t)(cb * 64 + wave * 8 + q) * DM) + lane;
#pragma unroll
            for (int j = 0; j < 4; ++j) vn[q][j] = xr[64 * j]; }
#pragma unroll 1
        for (int pp = 0; pp < 4; ++pp) {
            const int lr0 = wave * 8 + pp * 2, row0 = cb * 64 + lr0;
            f32x4 v[2][4]; float ss[2];
#pragma unroll
            for (int q = 0; q < 2; ++q)
#pragma unroll
                for (int j = 0; j < 4; ++j) v[q][j] = vn[q][j];
            if (pp < 3) {
#pragma unroll
                for (int q = 0; q < 2; ++q) { const f32x4* xr = (const f32x4*)(F.in[IN_X] + (size_t)(row0 + 2 + q) * DM) + lane;
#pragma unroll
                    for (int j = 0; j < 4; ++j) vn[q][j] = xr[64 * j]; } }
#pragma unroll
            for (int q = 0; q < 2; ++q) { float a = 0.f;
#pragma unroll
                for (int j = 0; j < 4; ++j) a += (v[q][j][0] * v[q][j][0] + v[q][j][1] * v[q][j][1]) + (v[q][j][2] * v[q][j][2] + v[q][j][3] * v[q][j][3]);
                ss[q] = a; }
            const float rinv0 = rsqf_(wave_sum(ss[0]) * (1.0f / DM) + EPS), rinv1 = rsqf_(wave_sum(ss[1]) * (1.0f / DM) + EPS);
#pragma unroll
            for (int j = 0; j < 4; ++j) { v[0][j] = (v[0][j] * rinv0) * mscale[j] + mshift[j]; v[1][j] = (v[1][j] * rinv1) * mscale[j] + mshift[j]; }
#pragma unroll
            for (int q = 0; q < 2; ++q) { u32x2* o8 = (u32x2*)(U + (size_t)(row0 + q) * DM) + lane;
#pragma unroll
                for (int j = 0; j < 4; ++j) { u32x2 w; w.x = cvt_pk_bf16(v[q][j][0], v[q][j][1]); w.y = cvt_pk_bf16(v[q][j][2], v[q][j][3]); o8[64 * j] = w;
                    *(LAS u32x2*)(ust + q * WSTR + (4 * lane + 256 * j) * 2) = w; } }
            f32x4 acc = (f32x4){0.f, 0.f, 0.f, 0.f};
#pragma unroll 8
            for (int ks = 0; ks < DM / 32; ++ks) { const int ko = (32 * ks + 8 * g) * 2;
                const bf16x8 Af = *(const LAS bf16x8*)(ust + (n16 & 1) * WSTR + ko);
                const bf16x8 Bh = *(const LAS bf16x8*)(L + OFF_W1H + n16 * WSTR + ko), Bl = *(const LAS bf16x8*)(L + OFF_W1L + n16 * WSTR + ko);
                acc = __builtin_amdgcn_mfma_f32_16x16x32_bf16(Af, Bh, acc, 0, 0, 0); acc = __builtin_amdgcn_mfma_f32_16x16x32_bf16(Af, Bl, acc, 0, 0, 0); }
            if (g == 0) { *(LAS float*)(L + OFF_A1T + ((lr0 + 0) * LOWRANK + n16) * 4) = acc[0]; *(LAS float*)(L + OFF_A1T + ((lr0 + 1) * LOWRANK + n16) * 4) = acc[1]; }
        }
        __syncthreads();
#if DIAG_A >= -1
        if (F.bid == 0 && F.tid == 0) ((unsigned long long*)(F.ctl + 1024))[14] = __builtin_amdgcn_s_memrealtime();
#endif
        { const int cp2 = F.tid & 255, half = F.tid >> 8; float w2a[LOWRANK], w2b[LOWRANK];
#pragma unroll
            for (int i = 0; i < LOWRANK; ++i) { const f32x2 w = *(const LAS f32x2*)(L + OFF_WA2 + (i * QKD + 2 * cp2) * 4); w2a[i] = w[0]; w2b[i] = w[1]; }
            const f32x2 bias = *(const f32x2*)(F.in[IN_BA2] + 2 * cp2); float ra[32], rb[32]; float runa = 0.f, runb = 0.f;
#pragma unroll
            for (int r = 0; r < 32; ++r) { float xa = bias[0], xb = bias[1];
#pragma unroll
                for (int i4 = 0; i4 < LOWRANK / 4; ++i4) { const f32x4 a = *(const LAS f32x4*)(L + OFF_A1T + ((32 * half + r) * LOWRANK + 4 * i4) * 4);
                    xa += (a[0] * w2a[4 * i4] + a[1] * w2a[4 * i4 + 1]) + (a[2] * w2a[4 * i4 + 2] + a[3] * w2a[4 * i4 + 3]);
                    xb += (a[0] * w2b[4 * i4] + a[1] * w2b[4 * i4 + 1]) + (a[2] * w2b[4 * i4 + 2] + a[3] * w2b[4 * i4 + 3]); }
                runa += (fminf(xa, 0.f) - __logf(1.0f + __expf(-fabsf(xa)))) * (1.0f / 16.0f); runb += (fminf(xb, 0.f) - __logf(1.0f + __expf(-fabsf(xb)))) * (1.0f / 16.0f);
                ra[r] = runa; rb[r] = runb; }
            *(LAS f32x2*)(L + OFF_TOT + (half * 256 + cp2) * 8) = (f32x2){runa, runb};
            __syncthreads();
            const f32x2 t0 = *(const LAS f32x2*)(L + OFF_TOT + cp2 * 8), t1 = *(const LAS f32x2*)(L + OFF_TOT + (256 + cp2) * 8);
            const float tota = t0[0] + t1[0], totb = t0[1] + t1[1];
            const float offa = (half ? t0[0] : 0.f) - tota, offb = (half ? t0[1] : 0.f) - totb;
            bf16_t* fo = FQ + (size_t)(cb * 64 + 32 * half) * QKD + 2 * cp2;
#pragma unroll
            for (int r = 0; r < 32; ++r) *(unsigned*)(fo + (size_t)r * QKD) = cvt_pk_bf16_c(__expf(ra[r] + offa), __expf(rb[r] + offb));
            if (half == 0) *(f32x2*)(EBL + (size_t)cb * QKD + 2 * cp2) = (f32x2){__expf(tota), __expf(totb)}; }
        __syncthreads();
    }
}

__device__ __forceinline__ void p2_scan_naive(Frame& F) {
    LAS float* qs = (LAS float*)F.lds;
    LAS float* ks = qs + 32 * 128;
    LAS float* es = ks + 32 * 128;
    LAS float* vs = es + 32 * 128;
    LAS float* po = vs + 32 * 32;
    const bf16_t* Q = (const bf16_t*)(F.ws + WS_Q); const bf16_t* Kb = (const bf16_t*)(F.ws + WS_K); bf16_t* V = (bf16_t*)(F.ws + WS_V); const float* LG = (const float*)(F.ws + WS_LG);
    const int e = F.tid & 31, dg = F.tid >> 5;
    for (int item = F.bid; item < BATCH * NH * 8; item += F.G) {
        const int sl = item & 7, h = (item >> 3) & 3, b = item >> 5;
        float S[8];
#pragma unroll
        for (int i = 0; i < 8; ++i) S[i] = 0.f;
        for (int t0 = 0; t0 < SEQ; t0 += 32) {
            const size_t rowb = (size_t)b * SEQ + t0;
            for (int i = F.tid; i < 32 * 128; i += NTHR) { const int t = i >> 7, d = i & 127;
                qs[i] = bf2f(Q[(rowb + t) * QKD + h * DK + d]); ks[i] = bf2f(Kb[(rowb + t) * QKD + h * DK + d]); es[i] = __expf(LG[(rowb + t) * QKD + h * DK + d]); }
            for (int i = F.tid; i < 32 * 32; i += NTHR) { const int t = i >> 5, ee = i & 31; vs[i] = bf2f(V[(rowb + t) * VD + h * DV + sl * 32 + ee]); }
            __syncthreads();
            for (int t = 0; t < 32; ++t) { const float vv = vs[t * 32 + e]; float p = 0.f;
#pragma unroll
                for (int i = 0; i < 8; ++i) { const int d = dg * 8 + i; S[i] = es[t * 128 + d] * S[i] + ks[t * 128 + d] * vv; p += qs[t * 128 + d] * S[i]; }
                po[(t * 16 + dg) * 32 + e] = p; }
            __syncthreads();
            for (int i = F.tid; i < 32 * 32; i += NTHR) { const int t = i >> 5, ee = i & 31; float s = 0.f;
#pragma unroll
                for (int q = 0; q < 16; ++q) s += po[(t * 16 + q) * 32 + ee];
                V[(rowb + t) * VD + h * DV + sl * 32 + ee] = (bf16_t)(cvt_pk_bf16(s, 0.f) & 0xffffu); }
            __syncthreads();
        }
    }
}

#define BAR_LDS() do { asm volatile("s_waitcnt lgkmcnt(0)" ::: "memory"); __builtin_amdgcn_s_barrier(); asm volatile("" ::: "memory"); } while (0)
namespace scan {
typedef short v4i16_t __attribute__((ext_vector_type(4)));
constexpr int QS = 272, VS = 80, KS = 144;
constexpr int SET_QI = 0, SET_KD = 64 * QS, SET_VV = 2 * 64 * QS, SET_EB = SET_VV + 64 * VS, SET_BYTES = SET_EB + 512;
constexpr int OFF_AT = 2 * SET_BYTES, OFF_SB = OFF_AT + 64 * KS, OFF_END = OFF_SB + 32 * QS;
static_assert(OFF_END <= MISC_OFF && SET_BYTES % 16 == 0, "scan LDS");
struct Ctx { LAS unsigned char* L; const unsigned char* qg; const unsigned char* kg; const unsigned char* vg; const unsigned char* eg; bf16_t* op; int tid, wave, c, g, mi, ne; };
struct Regs { u32x4 q[2], k[2], m; };
__device__ __forceinline__ void fetch(const Ctx& X, int ch, Regs& R) {
    const size_t rb = (size_t)ch * 64;
#pragma unroll
    for (int t = 0; t < 2; ++t) { const int p = X.tid + 512 * t, row = p >> 4, c16 = p & 15;
        R.q[t] = *(const u32x4*)(X.qg + (rb + row) * (QKD * 2) + c16 * 16); R.k[t] = *(const u32x4*)(X.kg + (rb + row) * (QKD * 2) + c16 * 16); }
    if (X.tid < 256) R.m = *(const u32x4*)(X.vg + (rb + (X.tid >> 2)) * (VD * 2) + (X.tid & 3) * 16);
    else if (X.tid < 288) R.m = *(const u32x4*)(X.eg + (size_t)ch * (QKD * 4) + (X.tid - 256) * 16);
}
__device__ __forceinline__ bf16x8 tr8(const LAS unsigned char* p0, const LAS unsigned char* p1) {
    const v4i16_t a = __builtin_amdgcn_ds_read_tr16_b64_v4i16((LAS v4i16_t*)p0), b = __builtin_amdgcn_ds_read_tr16_b64_v4i16((LAS v4i16_t*)p1);
    return (bf16x8){a[0], a[1], a[2], a[3], b[0], b[1], b[2], b[3]};
}
__device__ __forceinline__ void chunk(const Ctx& X, const int ch, Regs& R, f32x4 (&Sacc)[2]) {
    LAS unsigned char* S = X.L + (ch & 1) * SET_BYTES; LAS unsigned char* L = X.L;
    const int wave = X.wave, c = X.c, g = X.g, mi = X.mi, ne = X.ne, tid = X.tid;
#pragma unroll
    for (int t = 0; t < 2; ++t) { const int p = tid + 512 * t, row = p >> 4, c16 = p & 15;
        *(LAS u32x4*)(S + SET_QI + row * QS + c16 * 16) = R.q[t]; *(LAS u32x4*)(S + SET_KD + row * QS + c16 * 16) = R.k[t]; }
    if (tid < 256) *(LAS u32x4*)(S + SET_VV + (tid >> 2) * VS + (tid & 3) * 16) = R.m;
    else if (tid < 288) *(LAS u32x4*)(S + SET_EB + (tid - 256) * 16) = R.m;
    if (ch + 2 < SEQ / 64) fetch(X, ch + 2, R);
    BAR_LDS();
    f32x4 sa[2];
#pragma unroll
    for (int tt = 0; tt < 2; ++tt) { const int md = 2 * mi + tt;
        const f32x4 el = *(const LAS f32x4*)(S + SET_EB + (16 * md + 4 * g) * 4);
        sa[tt] = Sacc[tt] * el;
        *(LAS u32x2*)(L + OFF_SB + (16 * ne + c) * QS + (16 * md + 4 * g) * 2) = (u32x2){cvt_pk_bf16_c(sa[tt][0], sa[tt][1]), cvt_pk_bf16_c(sa[tt][2], sa[tt][3])}; }
#pragma unroll 1
    for (int tix = wave; tix < 10; tix += 8) {
        const int tm = (tix >= 6) ? 3 : (tix >= 3) ? 2 : (tix >= 1) ? 1 : 0; const int tn = tix - ((tm * (tm + 1)) >> 1);
        f32x4 a = (f32x4){0.f, 0.f, 0.f, 0.f};
#pragma unroll
        for (int ks = 0; ks < 4; ++ks) { const bf16x8 Af = *(const LAS bf16x8*)(S + SET_KD + (16 * tn + c) * QS + (32 * ks + 8 * g) * 2), Bf = *(const LAS bf16x8*)(S + SET_QI + (16 * tm + c) * QS + (32 * ks + 8 * g) * 2);
            a = __builtin_amdgcn_mfma_f32_16x16x32_bf16(Af, Bf, a, 0, 0, 0); }
        if (tm == tn) {
#pragma unroll
            for (int r = 0; r < 4; ++r) if (4 * g + r > c) a[r] = 0.f; }
        *(LAS u32x2*)(L + OFF_AT + (16 * tm + c) * KS + (16 * tn + 4 * g) * 2) = (u32x2){cvt_pk_bf16_c(a[0], a[1]), cvt_pk_bf16_c(a[2], a[3])};
    }
    BAR_LDS();
    const LAS unsigned char* vtr = S + SET_VV + (8 * g + (c >> 2)) * VS + (16 * ne + 4 * (c & 3)) * 2;
    const bf16x8 V0 = tr8(vtr, vtr + 4 * VS), V1 = tr8(vtr + 32 * VS, vtr + 36 * VS);
    f32x4 oacc = (f32x4){0.f, 0.f, 0.f, 0.f};
#pragma unroll
    for (int ks = 0; ks < 4; ++ks) { const bf16x8 Af = *(const LAS bf16x8*)(L + OFF_SB + (16 * ne + c) * QS + (32 * ks + 8 * g) * 2), Bf = *(const LAS bf16x8*)(S + SET_QI + (16 * mi + c) * QS + (32 * ks + 8 * g) * 2);
        oacc = __builtin_amdgcn_mfma_f32_16x16x32_bf16(Af, Bf, oacc, 0, 0, 0); }
    { const bf16x8 Bf = *(const LAS bf16x8*)(L + OFF_AT + (16 * mi + c) * KS + (8 * g) * 2); oacc = __builtin_amdgcn_mfma_f32_16x16x32_bf16(V0, Bf, oacc, 0, 0, 0); }
    if (mi >= 2) { const bf16x8 Bf = *(const LAS bf16x8*)(L + OFF_AT + (16 * mi + c) * KS + (32 + 8 * g) * 2); oacc = __builtin_amdgcn_mfma_f32_16x16x32_bf16(V1, Bf, oacc, 0, 0, 0); }
    *(u32x2*)(X.op + ((size_t)ch * 64 + 16 * mi + c) * VD) = (u32x2){cvt_pk_bf16_c(oacc[0], oacc[1]), cvt_pk_bf16_c(oacc[2], oacc[3])};
#pragma unroll
    for (int tt = 0; tt < 2; ++tt) { const int md = 2 * mi + tt;
        const LAS unsigned char* ktr = S + SET_KD + (8 * g + (c >> 2)) * QS + (16 * md + 4 * (c & 3)) * 2;
        const bf16x8 K0 = tr8(ktr, ktr + 4 * QS), K1 = tr8(ktr + 32 * QS, ktr + 36 * QS);
        f32x4 t = __builtin_amdgcn_mfma_f32_16x16x32_bf16(K0, V0, sa[tt], 0, 0, 0);
        Sacc[tt] = __builtin_amdgcn_mfma_f32_16x16x32_bf16(K1, V1, t, 0, 0, 0); }
}
}
__device__ __forceinline__ void p2_scan(Frame& F) {
    using namespace scan;
    Ctx X; X.L = F.lds; X.tid = F.tid; X.wave = F.wave; X.c = F.lane & 15; X.g = F.lane >> 4; X.mi = F.wave >> 1; X.ne = F.wave & 1;
    for (int item = F.bid; item < BATCH * NH * 8; item += F.G) {
        const int sl = item & 7, h = (item >> 3) & 3, b = item >> 5;
        for (int i = F.tid; i < 64 * KS / 4; i += NTHR) ((LAS unsigned*)(X.L + OFF_AT))[i] = 0u;
        f32x4 Sacc[2]; Sacc[0] = (f32x4){0.f, 0.f, 0.f, 0.f}; Sacc[1] = (f32x4){0.f, 0.f, 0.f, 0.f};
        const size_t row00 = (size_t)b * SEQ;
        X.qg = F.ws + WS_Q + (row00 * QKD + h * DK) * 2; X.kg = F.ws + WS_K + (row00 * QKD + h * DK) * 2;
        X.vg = F.ws + WS_V + (row00 * VD + h * DV + sl * 32) * 2; X.eg = F.ws + WS_EBL + ((size_t)(b * (SEQ / 64)) * QKD + h * DK) * 4;
        X.op = (bf16_t*)(F.ws + WS_V) + row00 * VD + h * DV + sl * 32 + 16 * X.ne + 4 * X.g;
        Regs RA, RB; RA.m = (u32x4){0u, 0u, 0u, 0u}; RB.m = RA.m;
        fetch(X, 0, RA); fetch(X, 1, RB);
#pragma unroll 1
        for (int ch = 0; ch < SEQ / 64; ch += 2) { chunk(X, ch, RA, Sacc); chunk(X, ch + 1, RB, Sacc); }
        BAR_LDS();
    }
}

__device__ __forceinline__ void p2_conv(Frame& F) {
    constexpr int TT = 32, HALO = CONV_W - 1, ROWS = TT + HALO;
    LAS bf16_t* zt = (LAS bf16_t*)F.lds;
    LAS float* wd = (LAS float*)(F.lds + 65536);
    for (int i = F.tid; i < CONV_W * CONV_DIM; i += NTHR) wd[i] = F.in[IN_WDW][i];
    const bf16_t* Z = (const bf16_t*)(F.ws + WS_Z); bf16_t* Z2 = (bf16_t*)(F.ws + WS_Z2);
    const int lane = F.lane, ch = 8 * lane;
    f32x4 bd0 = *(const f32x4*)(F.in[IN_BDW] + ch), bd1 = *(const f32x4*)(F.in[IN_BDW] + ch + 4);
    f32x4 lg0 = *(const f32x4*)(F.in[IN_GCLN] + ch), lg1 = *(const f32x4*)(F.in[IN_GCLN] + ch + 4);
    f32x4 lb0 = *(const f32x4*)(F.in[IN_BCLN] + ch), lb1 = *(const f32x4*)(F.in[IN_BCLN] + ch + 4);
    for (int tile = F.bid; tile < T / TT; tile += F.G) {
        const int t0 = tile * TT, s0 = t0 % SEQ;
        __syncthreads();
        for (int i = F.tid; i < ROWS * 64; i += NTHR) { const int r = i >> 6, c8 = i & 63; const int s = s0 - HALO + r;
            u32x4 w = (u32x4){0u, 0u, 0u, 0u};
            if (s >= 0) w = *(const u32x4*)(Z + (size_t)(t0 - HALO + r) * CONV_DIM + c8 * 8);
            *(LAS u32x4*)(zt + r * CONV_DIM + c8 * 8) = w; }
        __syncthreads();
        {
            const int tt0 = F.wave * 4;
            f32x4 acc[4][2];
#pragma unroll
            for (int i = 0; i < 4; ++i) { acc[i][0] = bd0; acc[i][1] = bd1; }
            f32x4 zr[4][2];
#pragma unroll
            for (int i = 0; i < 3; ++i) { const u32x4 zw = *(const LAS u32x4*)(zt + (tt0 + i) * CONV_DIM + ch);
                zr[i][0] = (f32x4){bflo(zw.x), bfhi(zw.x), bflo(zw.y), bfhi(zw.y)}; zr[i][1] = (f32x4){bflo(zw.z), bfhi(zw.z), bflo(zw.w), bfhi(zw.w)}; }
#pragma unroll
            for (int j = 0; j < CONV_W; ++j) { const u32x4 zw = *(const LAS u32x4*)(zt + (tt0 + j + 3) * CONV_DIM + ch);
                zr[3][0] = (f32x4){bflo(zw.x), bfhi(zw.x), bflo(zw.y), bfhi(zw.y)}; zr[3][1] = (f32x4){bflo(zw.z), bfhi(zw.z), bflo(zw.w), bfhi(zw.w)};
                const f32x4 w0 = *(const LAS f32x4*)(wd + j * CONV_DIM + ch), w1 = *(const LAS f32x4*)(wd + j * CONV_DIM + ch + 4);
#pragma unroll
                for (int i = 0; i < 4; ++i) { acc[i][0] += zr[i][0] * w0; acc[i][1] += zr[i][1] * w1; }
#pragma unroll
                for (int i = 0; i < 3; ++i) { zr[i][0] = zr[i + 1][0]; zr[i][1] = zr[i + 1][1]; } }
#pragma unroll
            for (int i = 0; i < 4; ++i) { f32x4 a0 = acc[i][0], a1 = acc[i][1];
                float sm = (a0[0] + a0[1]) + (a0[2] + a0[3]) + (a1[0] + a1[1]) + (a1[2] + a1[3]);
                const float mean = wave_sum(sm) * (1.0f / CONV_DIM);
                a0 -= mean; a1 -= mean;
                float q = (a0[0] * a0[0] + a0[1] * a0[1]) + (a0[2] * a0[2] + a0[3] * a0[3]) + (a1[0] * a1[0] + a1[1] * a1[1]) + (a1[2] * a1[2] + a1[3] * a1[3]);
                const float rstd = rsqf_(wave_sum(q) * (1.0f / CONV_DIM) + EPS);
                a0 = a0 * rstd * lg0 + lb0; a1 = a1 * rstd * lg1 + lb1;
                st_bf16x8(Z2 + (size_t)(t0 + tt0 + i) * CONV_DIM + ch, silu4(a0), silu4(a1)); }
        }
    }
    __syncthreads();
}

__device__ __forceinline__ void p2c_gate(Frame& F) {
    const bf16_t* O = (const bf16_t*)(F.ws + WS_V); bf16_t* RS = (bf16_t*)(F.ws + WS_RS);
    const int gw = F.bid * NWAVES + F.wave, NGW = F.G * NWAVES, lane = F.lane;
    f32x4 g[4];
#pragma unroll
    for (int j = 0; j < 4; ++j) g[j] = *(const f32x4*)(F.in[IN_GGLA] + 16 * lane + 4 * j);
    for (int row = gw; row < T; row += NGW) {
        f32x4 o[4], r[4];
        ld_bf16x8(O + (size_t)row * VD + 16 * lane, o[0], o[1]); ld_bf16x8(O + (size_t)row * VD + 16 * lane + 8, o[2], o[3]);
        ld_bf16x8(RS + (size_t)row * VD + 16 * lane, r[0], r[1]); ld_bf16x8(RS + (size_t)row * VD + 16 * lane + 8, r[2], r[3]);
        float ss = 0.f;
#pragma unroll
        for (int j = 0; j < 4; ++j) ss += (o[j][0] * o[j][0] + o[j][1] * o[j][1]) + (o[j][2] * o[j][2] + o[j][3] * o[j][3]);
        ss += __shfl_xor(ss, 1); ss += __shfl_xor(ss, 2); ss += __shfl_xor(ss, 4); ss += __shfl_xor(ss, 8);
        const float rinv = rsqf_(ss * (1.0f / DV) + EPS);
#pragma unroll
        for (int j = 0; j < 4; ++j) o[j] = (o[j] * rinv * g[j]) * r[j];
        st_bf16x8(RS + (size_t)row * VD + 16 * lane, o[0], o[1]); st_bf16x8(RS + (size_t)row * VD + 16 * lane + 8, o[2], o[3]);
    }
}

__device__ __forceinline__ void p5_router(Frame& F) {
    LAS float* wr = (LAS float*)F.lds;
    LAS int* hist = (LAS int*)(F.lds + (NGRP + NE) * DM * 4);
    LAS int* base = hist + 32;
    LAS int* stash = hist + 64;
    LAS float* breL = (LAS float*)(stash + 64 * 8);
    { const u32x4* src = (const u32x4*)(F.ws + WS_WRT); for (int i = F.tid; i < (NGRP + NE) * DM / 4; i += NTHR) ((LAS u32x4*)wr)[i] = src[i]; }
    if (F.tid < NE) breL[F.tid] = F.in[IN_BRE][F.tid];
    const float* mod = (const float*)(F.ws + WS_MOD);
    const float* Hh = F.out; bf16_t* U2 = (bf16_t*)(F.ws + WS_Q);
    int* lists = (int*)(F.ws + WS_LIST); int* tok = (int*)(F.ws + WS_TOK);
    const int lane = F.lane;
    float brg[NGRP];
#pragma unroll
    for (int j = 0; j < NGRP; ++j) brg[j] = F.in[IN_BRG][j];
    for (int rb = F.bid; rb < T / 64; rb += F.G) {
        if (F.tid < 32) hist[F.tid] = 0;
        __syncthreads();
        const int b = (rb * 64) / SEQ;
        const float* sh = mod + (size_t)b * NMOD * DM + 3 * DM; const float* sc = sh + DM;
        f32x4 mscale[4], mshift[4];
#pragma unroll
        for (int j = 0; j < 4; ++j) { const int k = 4 * lane + 256 * j; mscale[j] = *(const f32x4*)(F.in[IN_GN2] + k) * (*(const f32x4*)(sc + k) + 1.0f); mshift[j] = *(const f32x4*)(sh + k); }
        f32x4 vn[2][4];
#pragma unroll
        for (int q = 0; q < 2; ++q) { const f32x4* xr = (const f32x4*)(Hh + (size_t)(rb * 64 + F.wave * 8 + q) * DM) + lane;
#pragma unroll
            for (int j = 0; j < 4; ++j) vn[q][j] = xr[64 * j]; }
#pragma unroll 1
        for (int pp = 0; pp < 4; ++pp) {
            const int lr0 = F.wave * 8 + pp * 2, row0 = rb * 64 + lr0;
            f32x4 v[2][4]; float ss[2];
#pragma unroll
            for (int q = 0; q < 2; ++q)
#pragma unroll
                for (int j = 0; j < 4; ++j) v[q][j] = vn[q][j];
            if (pp < 3) {
#pragma unroll
                for (int q = 0; q < 2; ++q) { const f32x4* xr = (const f32x4*)(Hh + (size_t)(row0 + 2 + q) * DM) + lane;
#pragma unroll
                    for (int j = 0; j < 4; ++j) vn[q][j] = xr[64 * j]; } }
#pragma unroll
            for (int q = 0; q < 2; ++q) { float a = 0.f;
#pragma unroll
                for (int j = 0; j < 4; ++j) a += (v[q][j][0] * v[q][j][0] + v[q][j][1] * v[q][j][1]) + (v[q][j][2] * v[q][j][2] + v[q][j][3] * v[q][j][3]);
                ss[q] = a; }
            const float rinv0 = rsqf_(wave_sum(ss[0]) * (1.0f / DM) + EPS), rinv1 = rsqf_(wave_sum(ss[1]) * (1.0f / DM) + EPS);
#pragma unroll
            for (int j = 0; j < 4; ++j) { v[0][j] = (v[0][j] * rinv0) * mscale[j] + mshift[j]; v[1][j] = (v[1][j] * rinv1) * mscale[j] + mshift[j]; }
#pragma unroll
            for (int q = 0; q < 2; ++q) { u32x2* o8 = (u32x2*)(U2 + (size_t)(row0 + q) * DM) + lane;
#pragma unroll
                for (int j = 0; j < 4; ++j) { u32x2 w; w.x = cvt_pk_bf16(v[q][j][0], v[q][j][1]); w.y = cvt_pk_bf16(v[q][j][2], v[q][j][3]); o8[64 * j] = w; } }
            float lgg[2][NGRP];
#pragma unroll
            for (int i = 0; i < NGRP; ++i) { float s0 = 0.f, s1 = 0.f;
#pragma unroll
                for (int j = 0; j < 4; ++j) { const f32x4 w = *(const LAS f32x4*)(wr + i * DM + 4 * lane + 256 * j);
                    s0 += (v[0][j][0] * w[0] + v[0][j][1] * w[1]) + (v[0][j][2] * w[2] + v[0][j][3] * w[3]); s1 += (v[1][j][0] * w[0] + v[1][j][1] * w[1]) + (v[1][j][2] * w[2] + v[1][j][3] * w[3]); }
                lgg[0][i] = wave_sum(s0); lgg[1][i] = wave_sum(s1); }
#pragma unroll
            for (int q = 0; q < 2; ++q) {
                float gl[NGRP]; int gsel = 0;
#pragma unroll
                for (int j = 0; j < NGRP; ++j) gl[j] = lgg[q][j] + brg[j];
                float gmax = gl[0];
#pragma unroll
                for (int j = 1; j < NGRP; ++j) if (gl[j] > gmax) { gmax = gl[j]; gsel = j; }
                float den = 0.f;
#pragma unroll
                for (int j = 0; j < NGRP; ++j) den += __expf(gl[j] - gmax);
                const float wg = 1.0f / den;
                gsel = __builtin_amdgcn_readfirstlane(gsel);
                const LAS float* wre = wr + (NGRP + gsel * EPG) * DM + 4 * lane;
                float le[EPG];
#pragma unroll
                for (int j = 0; j < EPG; ++j) { float s0 = 0.f;
#pragma unroll
                    for (int jj = 0; jj < 4; ++jj) { const f32x4 w = *(const LAS f32x4*)(wre + j * DM + 256 * jj);
                        s0 += (v[q][jj][0] * w[0] + v[q][jj][1] * w[1]) + (v[q][jj][2] * w[2] + v[q][jj][3] * w[3]); }
                    le[j] = wave_sum(s0) + breL[gsel * EPG + j]; }
                int i0 = 0; float v0 = le[0];
#pragma unroll
                for (int j = 1; j < EPG; ++j) if (le[j] > v0) { v0 = le[j]; i0 = j; }
                int i1 = -1; float v1 = -3.0e38f;
#pragma unroll
                for (int j = 0; j < EPG; ++j) if (j != i0 && le[j] > v1) { v1 = le[j]; i1 = j; }
                const float e1 = __expf(v1 - v0); const float w0 = wg / (1.0f + e1), w1 = wg * e1 / (1.0f + e1);
                const int eid0 = gsel * EPG + i0, eid1 = gsel * EPG + i1;
                if (lane == 0) { const int r0 = atomicAdd((int*)(hist + eid0), 1), r1 = atomicAdd((int*)(hist + eid1), 1);
                    LAS int* st = stash + (lr0 + q) * 8; st[0] = eid0; st[1] = r0; st[2] = __float_as_int(w0); st[3] = eid1; st[4] = r1; st[5] = __float_as_int(w1); }
            }
        }
        __syncthreads();
        if (F.tid < 32) base[F.tid] = (int)atomicAdd(F.ctl + CW_CNT + F.tid, (unsigned)hist[F.tid]);
        __syncthreads();
        if (F.tid < 64) { const int row = rb * 64 + F.tid; const LAS int* st = stash + F.tid * 8;
            const int e0 = st[0], r0 = base[e0] + st[1], e1 = st[3], r1 = base[e1] + st[4];
            lists[(size_t)e0 * T + r0] = row; lists[(size_t)e1 * T + r1] = row;
            int* ti = tok + (size_t)row * 8; ti[0] = e0; ti[1] = r0; ti[2] = st[2]; ti[3] = e1; ti[4] = r1; ti[5] = st[5]; }
        __syncthreads();
    }
}

__device__ __forceinline__ void moe_table(Frame& F, LAS int* tbl) {
    if (F.tid < 64) { const int e = F.tid & 31;
        const int c = (int)__hip_atomic_load(F.ctl + CW_CNT + e, __ATOMIC_RELAXED, __HIP_MEMORY_SCOPE_AGENT);
        int incl = (c + 255) >> 8;
#pragma unroll
        for (int o = 1; o < 32; o <<= 1) { const int t = __shfl_up(incl, o, 32); if ((F.tid & 31) >= o) incl += t; }
        if (F.tid < 32) { tbl[e] = incl - ((c + 255) >> 8); tbl[40 + e] = c; if (e == 31) tbl[NE] = incl; } }
    __syncthreads();
}

__device__ __forceinline__ void p8_final(Frame& F) {
    LAS int* tbl = (LAS int*)(F.lds + TBL_OFF);
    moe_table(F, tbl);
    const float* mod = (const float*)(F.ws + WS_MOD); const float* modf = mod + BATCH * NMOD * DM;
    const bf16_t* Y = (const bf16_t*)(F.ws + WS_Y); const int* tok = (const int*)(F.ws + WS_TOK);
    const int lane = F.lane;
    for (int rb = F.bid; rb < T / 64; rb += F.G) {
        const int b = (rb * 64) / SEQ, rbase = rb * 64 + F.wave * 8;
        const float* ga = mod + (size_t)b * NMOD * DM + 5 * DM; const float* sh = modf + (size_t)b * 2 * DM; const float* sc = sh + DM;
        f32x4 gav[4], fscale[4], fshift[4];
#pragma unroll
        for (int j = 0; j < 4; ++j) { const int k = 4 * lane + 256 * j; gav[j] = *(const f32x4*)(ga + k); fscale[j] = *(const f32x4*)(F.in[IN_GFIN] + k) * (*(const f32x4*)(sc + k) + 1.0f); fshift[j] = *(const f32x4*)(sh + k); }
        int tin[6]; f32x4 hn[4];
        { const int* ti = tok + (size_t)rbase * 8;
#pragma unroll
            for (int i = 0; i < 6; ++i) tin[i] = ti[i];
            const f32x4* hr = (const f32x4*)(F.out + (size_t)rbase * DM) + lane;
#pragma unroll
            for (int j = 0; j < 4; ++j) hn[j] = hr[64 * j]; }
#pragma unroll 1
        for (int rr = 0; rr < 8; ++rr) {
            const int row = rbase + rr;
            const int e0 = tin[0], r0 = tin[1], e1 = tin[3], r1 = tin[4]; const float w0 = __int_as_float(tin[2]), w1 = __int_as_float(tin[5]);
            const size_t s0 = (size_t)tbl[e0] * 256 + r0, s1 = (size_t)tbl[e1] * 256 + r1;
            const u32x2* y0 = (const u32x2*)(Y + s0 * DM) + lane; const u32x2* y1 = (const u32x2*)(Y + s1 * DM) + lane;
            u32x2 ya[4], yc[4]; f32x4 hv[4];
#pragma unroll
            for (int j = 0; j < 4; ++j) { ya[j] = y0[64 * j]; yc[j] = y1[64 * j]; hv[j] = hn[j]; }
            if (rr < 7) { const int* ti = tok + (size_t)(row + 1) * 8;
#pragma unroll
                for (int i = 0; i < 6; ++i) tin[i] = ti[i];
                const f32x4* hr = (const f32x4*)(F.out + (size_t)(row + 1) * DM) + lane;
#pragma unroll
                for (int j = 0; j < 4; ++j) hn[j] = hr[64 * j]; }
            f32x4 v[4]; float ss = 0.f;
#pragma unroll
            for (int j = 0; j < 4; ++j) { const u32x2 a = ya[j], c = yc[j];
                const f32x4 fa = (f32x4){bflo(a.x), bfhi(a.x), bflo(a.y), bfhi(a.y)}, fc = (f32x4){bflo(c.x), bfhi(c.x), bflo(c.y), bfhi(c.y)};
                v[j] = hv[j] + gav[j] * (fa * w0 + fc * w1);
                ss += (v[j][0] * v[j][0] + v[j][1] * v[j][1]) + (v[j][2] * v[j][2] + v[j][3] * v[j][3]); }
            const float rinv = rsqf_(wave_sum(ss) * (1.0f / DM) + EPS);
            f32x4* orow = (f32x4*)(F.out + (size_t)row * DM) + lane;
#pragma unroll
            for (int j = 0; j < 4; ++j) orow[64 * j] = (v[j] * rinv) * fscale[j] + fshift[j];
        }
    }
}

constexpr int NPHASE = 11;
struct Args { const float* in[28]; float* out; unsigned char* ws; int ph_lo, ph_hi; };
__global__ void __launch_bounds__(NTHR, 2) fwd_kernel(Args args) {
    extern __shared__ __attribute__((aligned(16))) unsigned char lds[];
    Frame F;
    F.lds = (LAS unsigned char*)lds;
    F.MISC = (volatile LAS unsigned*)(F.lds + MISC_OFF);
    F.tid = threadIdx.x; F.lane = F.tid & 63; F.wave = __builtin_amdgcn_readfirstlane(F.tid >> 6);
    F.G = gridDim.x; F.bid = blockIdx.x;
    F.ws = args.ws; F.out = args.out; F.ctl = (unsigned*)(args.ws + WS_CTL);
#pragma unroll
    for (int i = 0; i < 28; ++i) F.in[i] = args.in[i];
    if (F.tid < 128) F.MISC[F.tid] = 0u;
    __syncthreads();
    const int lo = args.ph_lo, hi = args.ph_hi;
    XcdBarrier bar; bar.bar = F.ctl + CW_BAR; bar.x = 0; bar.st = nullptr;
    if (hi - lo > 1) bar = xcd_barrier_post(F.ctl + CW_BAR, F.MISC + 8);
#define IN(k) (lo <= (k) && (k) < hi)
#if DIAG_A >= -1
    unsigned long long* const ts = (unsigned long long*)(F.ctl + 1024);
    if (F.bid == 0 && F.tid == 0) ts[0] = __builtin_amdgcn_s_memrealtime();
#define SEAM(k) do { if (IN(k) && IN((k) + 1)) xcd_barrier(bar); if (F.bid == 0 && F.tid == 0) ts[(k) + 1] = __builtin_amdgcn_s_memrealtime(); } while (0)
#else
#define SEAM(k) do { if (IN(k) && IN((k) + 1)) xcd_barrier(bar); } while (0)
#endif
    LAS unsigned char* ring = F.lds;

    for (int rep_ = 0; rep_ < ((DIAG_R == 0) ? 2 : 1); ++rep_) if (IN(0)) { p0_prologue(F); } SEAM(0);
    for (int rep_ = 0; rep_ < ((DIAG_R == 1) ? 2 : 1); ++rep_) if (IN(1)) { p1a_norm(F); } SEAM(1);
    for (int rep_ = 0; rep_ < ((DIAG_R == 2) ? 2 : 1); ++rep_) if (IN(2)) {
        pg8::DenseOrder S; S.init(F.ws + WS_U, F.ws + WS_WIN, T, NPROJ, DM, F.G, F.bid);
        EpiProj E{F.ws, (unsigned char*)F.out};
        pg8::gemm_phase<EpiProj, pg8::DenseOrder, false>(ring, DM, S, E);
    } SEAM(2);
    if (IN(3)) { p2_scan(F);
#if DIAG_A >= -1
        if (F.bid == 0 && F.tid == 0) ts[12] = __builtin_amdgcn_s_memrealtime();
#endif
        p2_conv(F); } SEAM(3);
    if (IN(4)) {
        p2c_gate(F);
        __syncthreads();
        pg8::DenseOrder S; S.init(F.ws + WS_Z2, F.ws + WS_WPW, T, DM, CONV_DIM, F.G, F.bid);
        EpiConvPw E{(bf16_t*)(F.ws + WS_U), (const bf16_t*)F.out, F.in[IN_BPW]};
        pg8::gemm_phase<EpiConvPw, pg8::DenseOrder, false>(ring, CONV_DIM, S, E);
    } SEAM(4);
    if (IN(5)) {
        pg8::DenseOrder S; S.init(F.ws + WS_RS, F.ws + WS_WGO, T, DM, VD, F.G, F.bid);
        EpiMerge E{(bf16_t*)(F.ws + WS_U), (const bf16_t*)F.out};
        pg8::gemm_phase<EpiMerge, pg8::DenseOrder, false>(ring, VD, S, E);
    } SEAM(5);
    for (int rep_ = 0; rep_ < ((DIAG_R == 6) ? 2 : 1); ++rep_) if (IN(6)) {
        pg8::DenseOrder S; S.init(F.ws + WS_U, F.ws + WS_WOUT, T, DM, DM, F.G, F.bid);
        EpiH E{F.in[IN_X], F.out, (const float*)(F.ws + WS_MOD)};
        pg8::gemm_phase<EpiH, pg8::DenseOrder, false>(ring, DM, S, E);
    } SEAM(6);
    if (IN(7)) { p5_router(F); } SEAM(7);
    for (int rep_ = 0; rep_ < ((DIAG_R == 8) ? 2 : 1); ++rep_) if (IN(8)) {
        LAS int* tbl = (LAS int*)(F.lds + TBL_OFF);
        moe_table(F, tbl);
        MoeOrder S; S.tstart = tbl; S.cnt = tbl + 40; S.G = F.G; S.c = F.bid; S.NT = 4; S.A = (const char*)(F.ws + WS_Q); S.W = (const char*)(F.ws + WS_W13);
        S.lists = (const int*)(F.ws + WS_LIST); S.wstride = (size_t)(2 * DE) * DM * 2; S.astride_tile = 0; S.wtile = (size_t)256 * DM * 2; S.gather = true;
        EpiUp E{(bf16_t*)(F.ws + WS_HID)};
        pg8::gemm_phase<EpiUp, MoeOrder, true>(ring, DM, S, E);
    } SEAM(8);
    for (int rep_ = 0; rep_ < ((DIAG_R == 9) ? 2 : 1); ++rep_) if (IN(9)) {
        LAS int* tbl = (LAS int*)(F.lds + TBL_OFF);
        moe_table(F, tbl);
        MoeOrder S; S.tstart = tbl; S.cnt = tbl + 40; S.G = F.G; S.c = F.bid; S.NT = 4; S.A = (const char*)(F.ws + WS_HID); S.W = (const char*)(F.ws + WS_W2);
        S.lists = nullptr; S.wstride = (size_t)DM * DE * 2; S.astride_tile = (size_t)256 * DE * 2; S.wtile = (size_t)256 * DE * 2; S.gather = false;
        EpiDown E{(bf16_t*)(F.ws + WS_Y)};
        pg8::gemm_phase<EpiDown, MoeOrder, false>(ring, DE, S, E);
    } SEAM(9);
    if (IN(10)) { p8_final(F); }
#if DIAG_A >= -1
    xcd_barrier(bar);
    if (F.bid == 0) {
        if (F.tid == 0) ts[11] = __builtin_amdgcn_s_memrealtime();
        __syncthreads();
        const float tot = (float)(ts[11] - ts[0]);
        const float fa = (DIAG_A == 30) ? (float)(ts[12] - ts[3]) / tot : (DIAG_A == 31) ? (float)(ts[13] - ts[1]) / tot : (DIAG_A == 32) ? (float)(ts[14] - ts[13]) / tot : (DIAG_A >= 0) ? (float)(ts[(DIAG_A >= 0 && DIAG_A < 11 ? DIAG_A : 0) + 1] - ts[(DIAG_A >= 0 && DIAG_A < 11 ? DIAG_A : 0)]) / tot : 1.0f;
        if (F.tid == 0) F.out[0] += 3.0f + 40.0f * fa;
    }
#endif
#undef IN
#undef SEAM
}

extern "C" void kernel_launch(void* const* d_in, const int* in_sizes, int n_in, void* d_out, int out_size, void* d_ws, size_t ws_size, hipStream_t stream) {
    static int grid = 0;
    if (grid == 0) {
        if (n_in != 28 || in_sizes[0] != T * DM || out_size != T * DM || ws_size < WS_END) {
            fprintf(stderr, "kernel_launch: shape / workspace mismatch (n_in %d, in0 %d, out %d, ws %zu, need %zu)\n", n_in, n_in > 0 ? in_sizes[0] : -1, out_size, ws_size, (size_t)WS_END); grid = -1; return; }
        int dev = 0, cus = 0, per_cu = 0;
        if (hipGetDevice(&dev) != hipSuccess || hipDeviceGetAttribute(&cus, hipDeviceAttributeMultiprocessorCount, dev) != hipSuccess) { grid = -1; return; }
        if (hipFuncSetAttribute((const void*)fwd_kernel, hipFuncAttributeMaxDynamicSharedMemorySize, LDS_BYTES) != hipSuccess) { fprintf(stderr, "kernel_launch: hipFuncSetAttribute failed\n"); grid = -1; return; }
        if (hipOccupancyMaxActiveBlocksPerMultiprocessor(&per_cu, (const void*)fwd_kernel, NTHR, LDS_BYTES) != hipSuccess || per_cu < 1) {
            fprintf(stderr, "kernel_launch: occupancy query reports %d workgroups per CU\n", per_cu); (void)hipGetLastError(); grid = -1; return; }
        grid = cus;
    }
    if (grid < 0) return;
    if (hipMemsetAsync((char*)d_ws + WS_CTL, 0, CTL_ZERO_BYTES, stream) != hipSuccess) return;
    Args a{};
    for (int i = 0; i < 28; ++i) a.in[i] = (const float*)d_in[i];
    a.out = (float*)d_out; a.ws = (unsigned char*)d_ws;
#if MK_N_LAUNCHES == 1
    a.ph_lo = 0; a.ph_hi = NPHASE;
    hipLaunchKernelGGL(fwd_kernel, dim3(grid), dim3(NTHR), LDS_BYTES, stream, a);
#else
    for (int p = 0; p < NPHASE; ++p) { a.ph_lo = p; a.ph_hi = p + 1; hipLaunchKernelGGL(fwd_kernel, dim3(grid), dim3(NTHR), LDS_BYTES, stream, a); }
#endif
}
```
